# Optimizing an MI355X kernel written in HIP

```python
import jax
import jax.numpy as jnp
from jax import lax
import numpy as np

D_MODEL = 1024
BATCH = 2
SEQ = 8192
DEPTH = 2

GRID_W = 64
CTX_LEN = 256
N_MOD = 9
D_FF = 2816
GLA_HEADS = 4
GLA_DK = 64
GLA_DV = 128
GLA_GATE_RANK = 16
GLA_TAU = 16.0
GLA_CHUNK = 64
FOURIER_GROUPS = 4
FOURIER_CH = 128
MLA_HEADS = 8
MLA_NOPE = 64
MLA_ROPE = 32
MLA_V = 64
MLA_Q_RANK = 384
MLA_KV_RANK = 256
ROPE_BASE = 10000.0
Q_BLOCK = 128
N_BRANCH = 3
BRANCH_W = 512
EPS = 1e-6
IN_SPLIT = (
    ('gla_q', GLA_HEADS * GLA_DK),
    ('gla_k', GLA_HEADS * GLA_DK),
    ('gla_v', GLA_HEADS * GLA_DV),
    ('gla_g', GLA_HEADS * GLA_DV),
    ('gla_a_f', GLA_GATE_RANK),
    ('gla_a_b', GLA_GATE_RANK),
    ('fourier', FOURIER_GROUPS * FOURIER_CH),
    ('mla_cq', MLA_Q_RANK),
    ('mla_ckv', MLA_KV_RANK),
    ('mla_kr', MLA_ROPE),
    ('gates', N_BRANCH * D_MODEL),
)
D_IN = sum(s for _, s in IN_SPLIT)

kernel_name = 'hybrid_gla_fnet_mla_macaron'


def _rmsnorm(x, g):
    xf = x.astype(jnp.float32)
    y = xf * lax.rsqrt(jnp.mean(xf * xf, axis=-1, keepdims=True) + EPS)
    return (y * g.astype(jnp.float32)).astype(x.dtype)


def _modulation(cond, w, b):
    m = jax.nn.silu(cond) @ w + b
    return jnp.split(m[:, None, :], N_MOD, axis=-1)


def _half_ffn(x, mod, g_pre, g_post, wg, wu, wd):
    shift, scale, gate = mod
    h = _rmsnorm(x, g_pre) * (1 + scale) + shift
    y = (jax.nn.silu(h @ wg) * (h @ wu)) @ wd
    return x + 0.5 * gate * _rmsnorm(y, g_post)


def _split_in(z):
    out = {}
    off = 0
    for name, size in IN_SPLIT:
        out[name] = z[..., off:off + size]
        off += size
    return out


def _axial_rope_tables(n):
    ROWS = n // GRID_W
    rows = jnp.repeat(jnp.arange(ROWS, dtype=jnp.float32), GRID_W)
    cols = jnp.tile(jnp.arange(GRID_W, dtype=jnp.float32), ROWS)
    half = MLA_ROPE // 2
    inv_freq = ROPE_BASE ** (-jnp.arange(0, half, 2, dtype=jnp.float32) / half)
    ang_r = rows[:, None] * inv_freq
    ang_c = cols[:, None] * inv_freq
    return (jnp.cos(ang_r)[:, None], jnp.sin(ang_r)[:, None], jnp.cos(ang_c)[:, None], jnp.sin(ang_c)[:, None])


def _rotate(x, cos, sin):
    h = x.shape[-1] // 2
    x1, x2 = x[..., :h], x[..., h:]
    return jnp.concatenate([x1 * cos - x2 * sin, x2 * cos + x1 * sin], axis=-1)


def _rope2d(x, tabs):
    cr, sr, cc, sc = tabs
    xf = x.astype(jnp.float32)
    a = MLA_ROPE // 2
    out = jnp.concatenate([_rotate(xf[..., :a], cr, sr), _rotate(xf[..., a:], cc, sc)], axis=-1)
    return out.astype(x.dtype)


def _gla_chunked(q, k, v, log_a, s0):
    b, n, h, dk = q.shape
    dv = v.shape[-1]
    nc = n // GLA_CHUNK

    def chunks(t):
        return t.astype(jnp.float32).reshape(b, nc, GLA_CHUNK, h, t.shape[-1]).transpose(1, 0, 3, 2, 4)

    tril = jnp.tril(jnp.ones((GLA_CHUNK, GLA_CHUNK), bool))[:, :, None]

    def step(state, inp):
        qc, kc, vc, gc = inp
        cum = jnp.cumsum(gc, axis=2)
        rel = jnp.where(tril, cum[:, :, :, None, :] - cum[:, :, None, :, :], -jnp.inf)
        attn = jnp.einsum('bhtd,bhtsd,bhsd->bhts', qc, jnp.exp(rel), kc)
        out = jnp.einsum('bhts,bhse->bhte', attn, vc) + jnp.einsum('bhtd,bhde->bhte', qc * jnp.exp(cum), state)
        tot = cum[:, :, -1:, :]
        state = jnp.exp(tot)[:, :, 0, :, None] * state + jnp.einsum('bhsd,bhse->bhde', kc * jnp.exp(tot - cum), vc)
        return state, out

    s_fin, o = lax.scan(step, s0, (chunks(q), chunks(k), chunks(v), chunks(log_a)))
    return o.transpose(1, 0, 3, 2, 4).reshape(b, n, h, dv), s_fin


def _gla_branch(z, s0_f, s0_b, w_dec, b_dec, g_norm):
    b, n, _ = z['gla_q'].shape
    dt = z['gla_v'].dtype

    def heads(t, d):
        return t.reshape(b, n, GLA_HEADS, d)

    q = heads(z['gla_q'], GLA_DK) * GLA_DK ** -0.5
    k = heads(z['gla_k'], GLA_DK)
    v = heads(z['gla_v'], GLA_DV)
    la_f = heads(jax.nn.log_sigmoid((z['gla_a_f'] @ w_dec[0] + b_dec[0]).astype(jnp.float32)) / GLA_TAU, GLA_DK)
    la_b = heads(jax.nn.log_sigmoid((z['gla_a_b'] @ w_dec[1] + b_dec[1]).astype(jnp.float32)) / GLA_TAU, GLA_DK)
    o_f, s_f = _gla_chunked(q, k, v, la_f, s0_f)
    o_b, s_b = _gla_chunked(q[:, ::-1], k[:, ::-1], v[:, ::-1], la_b[:, ::-1], s0_b)
    o = (o_f + o_b[:, ::-1]).astype(dt)
    y = _rmsnorm(o, g_norm) * jax.nn.silu(heads(z['gla_g'], GLA_DV))
    return y.reshape(b, n, GLA_HEADS * GLA_DV), s_f, s_b


def _fourier(f):
    b, n, _ = f.shape
    g = f.astype(jnp.float32).reshape(b, n, FOURIER_GROUPS, FOURIER_CH)
    y = jnp.fft.fft2(g, axes=(1, 3), norm='ortho').real
    return y.reshape(b, n, FOURIER_GROUPS * FOURIER_CH).astype(f.dtype)


def _mla_project(z, q_norm, w_uq, kv_norm, w_ukv):
    b, n, _ = z['mla_cq'].shape
    q = (_rmsnorm(z['mla_cq'], q_norm) @ w_uq).reshape(b, n, MLA_HEADS, MLA_NOPE + MLA_ROPE)
    kv = (_rmsnorm(z['mla_ckv'], kv_norm) @ w_ukv).reshape(b, n, MLA_HEADS, MLA_NOPE + MLA_V)
    return q[..., :MLA_NOPE], q[..., MLA_NOPE:], kv[..., :MLA_NOPE], z['mla_kr'], kv[..., MLA_NOPE:]


def _mla_context_attention(qn, qr, kn, kr, v):
    scale = (MLA_NOPE + MLA_ROPE) ** -0.5
    s = jnp.einsum('bqhd,bkhd->bhqk', qn, kn) + jnp.einsum('bqhr,bkr->bhqk', qr, kr)
    p = jax.nn.softmax(s.astype(jnp.float32) * scale, axis=-1).astype(v.dtype)
    o = jnp.einsum('bhqk,bkhe->bqhe', p, v)
    return o.reshape(o.shape[0], o.shape[1], MLA_HEADS * MLA_V)


def _mla_latent_attention(qn, qr, kn, kr, v, kn_c, kr_c, v_c):
    b, n, h, _ = qn.shape
    nb = n // Q_BLOCK
    scale = (MLA_NOPE + MLA_ROPE) ** -0.5

    def blocks(t):
        return t.reshape(b, nb, Q_BLOCK, *t.shape[2:]).swapaxes(0, 1)

    def attend(blk):
        qn_i, qr_i = blk
        s_lat = jnp.einsum('bqhd,bkhd->bhqk', qn_i, kn) + jnp.einsum('bqhr,bkr->bhqk', qr_i, kr)
        s_ctx = jnp.einsum('bqhd,bkhd->bhqk', qn_i, kn_c) + jnp.einsum('bqhr,bkr->bhqk', qr_i, kr_c)
        s = jnp.concatenate([s_lat, s_ctx], axis=-1).astype(jnp.float32) * scale
        p = jax.nn.softmax(s, axis=-1).astype(v.dtype)
        return jnp.einsum('bhqk,bkhe->bqhe', p[..., :n], v) + jnp.einsum('bhqk,bkhe->bqhe', p[..., n:], v_c)

    o = lax.map(attend, (blocks(qn), blocks(qr)))
    return o.swapaxes(0, 1).reshape(b, n, h * MLA_V)


def _merge(ya, yb, yc, gates, w_branch, w_out):
    g = jax.nn.sigmoid(gates.astype(jnp.float32)).astype(ya.dtype)
    ga, gb, gc = jnp.split(g, N_BRANCH, axis=-1)
    m = ga * (ya @ w_branch[0]) + gb * (yb @ w_branch[1]) + gc * (yc @ w_branch[2])
    return m @ w_out


def _token_mixing(xl, xc, mod_l, mod_c, g_pre, g_post, w_in, w_dec, b_dec, g_gla, q_norm, w_uq, kv_norm, w_ukv, w_branch, w_out, rope, ctx_out):
    shift_l, scale_l, gate_l = mod_l
    shift_c, scale_c, gate_c = mod_c
    hl = _rmsnorm(xl, g_pre) * (1 + scale_l) + shift_l
    hc = _rmsnorm(xc, g_pre) * (1 + scale_c) + shift_c
    zl = _split_in(hl @ w_in)
    zc = _split_in(hc @ w_in)
    zero = jnp.zeros((xc.shape[0], GLA_HEADS, GLA_DK, GLA_DV), jnp.float32)
    ya_c, s_f, s_b = _gla_branch(zc, zero, zero, w_dec, b_dec, g_gla)
    ya_l, _, _ = _gla_branch(zl, s_f, s_b, w_dec, b_dec, g_gla)
    yb_l = _fourier(zl['fourier'])
    qn_c, qr_c, kn_c, kr_c, v_c = _mla_project(zc, q_norm, w_uq, kv_norm, w_ukv)
    qn_l, qr_l, kn_l, kr_l, v_l = _mla_project(zl, q_norm, w_uq, kv_norm, w_ukv)
    qr_l = _rope2d(qr_l, rope)
    kr_l = _rope2d(kr_l[:, :, None, :], rope)[:, :, 0, :]
    yc_l = _mla_latent_attention(qn_l, qr_l, kn_l, kr_l, v_l, kn_c, kr_c, v_c)
    xl = xl + gate_l * _rmsnorm(_merge(ya_l, yb_l, yc_l, zl['gates'], w_branch, w_out), g_post)
    if ctx_out:
        yb_c = _fourier(zc['fourier'])
        yc_c = _mla_context_attention(qn_c, qr_c, kn_c, kr_c, v_c)
        xc = xc + gate_c * _rmsnorm(_merge(ya_c, yb_c, yc_c, zc['gates'], w_branch, w_out), g_post)
    return xl, xc


def setup_inputs(seed: int = 0) -> dict:
    key = jax.random.key(seed)
    ks = jax.random.split(key, 21)
    L, D = DEPTH, D_MODEL

    def nrm(k, shape, scale=1.0):
        return scale * jax.random.normal(k, shape, jnp.float32)

    return {
        'x': nrm(ks[0], (BATCH, SEQ, D)),
        'c': nrm(ks[1], (BATCH, D)),
        'ctx': nrm(ks[2], (BATCH, CTX_LEN, D)),
        'c_ctx': nrm(ks[3], (D,)),
        'w_mod': nrm(ks[4], (L, D, N_MOD * D), 0.5 * D ** -0.5),
        'b_mod': nrm(ks[5], (L, N_MOD * D), 0.01),
        'norm_pre': 1.0 + nrm(ks[6], (L, 3, D), 0.02),
        'norm_post': 1.0 + nrm(ks[7], (L, 3, D), 0.02),
        'ffn_w_gate': nrm(ks[8], (L, 2, D, D_FF), D ** -0.5),
        'ffn_w_up': nrm(ks[9], (L, 2, D, D_FF), D ** -0.5),
        'ffn_w_down': nrm(ks[10], (L, 2, D_FF, D), D_FF ** -0.5),
        'w_in': nrm(ks[11], (L, D, D_IN), D ** -0.5),
        'gla_w_decay': nrm(ks[12], (L, 2, GLA_GATE_RANK, GLA_HEADS * GLA_DK), GLA_GATE_RANK ** -0.5),
        'gla_b_decay': nrm(ks[13], (L, 2, GLA_HEADS * GLA_DK), 0.01),
        'gla_norm': 1.0 + nrm(ks[14], (L, GLA_DV), 0.02),
        'mla_q_norm': 1.0 + nrm(ks[15], (L, MLA_Q_RANK), 0.02),
        'mla_w_uq': nrm(ks[16], (L, MLA_Q_RANK, MLA_HEADS * (MLA_NOPE + MLA_ROPE)), MLA_Q_RANK ** -0.5),
        'mla_kv_norm': 1.0 + nrm(ks[17], (L, MLA_KV_RANK), 0.02),
        'mla_w_ukv': nrm(ks[18], (L, MLA_KV_RANK, MLA_HEADS * (MLA_NOPE + MLA_V)), MLA_KV_RANK ** -0.5),
        'w_branch': nrm(ks[19], (L, N_BRANCH, BRANCH_W, D), BRANCH_W ** -0.5),
        'w_out': nrm(ks[20], (L, D, D), D ** -0.5),
    }


def reference(x, c, ctx, c_ctx, w_mod, b_mod, norm_pre, norm_post, ffn_w_gate, ffn_w_up, ffn_w_down, w_in, gla_w_decay, gla_b_decay, gla_norm, mla_q_norm, mla_w_uq, mla_kv_norm, mla_w_ukv, w_branch, w_out):
    rope = _axial_rope_tables(x.shape[1])
    xl, xc = x, ctx
    for layer in range(DEPTH):
        last = layer == DEPTH - 1
        mod_l = _modulation(c, w_mod[layer], b_mod[layer])
        mod_c = _modulation(c_ctx[None, :], w_mod[layer], b_mod[layer])
        ffn_a = (norm_pre[layer, 0], norm_post[layer, 0], ffn_w_gate[layer, 0], ffn_w_up[layer, 0], ffn_w_down[layer, 0])
        ffn_b = (norm_pre[layer, 2], norm_post[layer, 2], ffn_w_gate[layer, 1], ffn_w_up[layer, 1], ffn_w_down[layer, 1])
        xl = _half_ffn(xl, mod_l[0:3], *ffn_a)
        xc = _half_ffn(xc, mod_c[0:3], *ffn_a)
        xl, xc = _token_mixing(xl, xc, mod_l[3:6], mod_c[3:6], norm_pre[layer, 1], norm_post[layer, 1], w_in[layer], gla_w_decay[layer], gla_b_decay[layer], gla_norm[layer], mla_q_norm[layer], mla_w_uq[layer], mla_kv_norm[layer], mla_w_ukv[layer], w_branch[layer], w_out[layer], rope, not last)
        xl = _half_ffn(xl, mod_l[6:9], *ffn_b)
        if not last:
            xc = _half_ffn(xc, mod_c[6:9], *ffn_b)
    return xl
```

```cpp
#include <hip/hip_runtime.h>
#include <hip/hip_cooperative_groups.h>
#include <stdint.h>
#include <cstdio>
namespace cg = cooperative_groups;

#ifndef DUP_MASK
#define DUP_MASK 0
#endif
#ifndef MK_PER_PHASE
#define MK_PER_PHASE 0
#endif

typedef unsigned short bf16;
typedef short bf16x8 __attribute__((ext_vector_type(8)));
typedef float f32x4 __attribute__((ext_vector_type(4)));
typedef unsigned v4u __attribute__((ext_vector_type(4)));
typedef unsigned v2u __attribute__((ext_vector_type(2)));
#define DEVI __device__ __forceinline__
#define GAS __attribute__((address_space(1)))
#define LAS __attribute__((address_space(3)))

constexpr int D = 1024, NB = 2, SEQ = 8192, CTXL = 256, ML = NB * SEQ, MC = NB * CTXL, MT = ML + MC;
constexpr int DFF = 2816, NGU = 2 * DFF, DIN = 5824, NZ = 2304, NWIN = 3328, NPOS = SEQ + CTXL;
constexpr int NMOD = 9 * D;
constexpr float EPS = 1e-6f;
constexpr int NTHREADS = 256;
constexpr int LDS_MAIN = 73728;
constexpr int LDS_BYTES = LDS_MAIN + 64;
constexpr int NPHASES = 32;

constexpr size_t al(size_t x) { return (x + 255) & ~(size_t)255; }
constexpr size_t OFF_BAR = 0;
constexpr size_t BAR_BYTES = 16384;
constexpr size_t OFF_MOD = BAR_BYTES;
constexpr size_t OFF_ROPE = al(OFF_MOD + (size_t)2 * 3 * NMOD * 4);
constexpr size_t OFF_TW = al(OFF_ROPE + 128 * 8 * 2 * 4);
constexpr size_t OFF_DEC = al(OFF_TW + 4096 * 2 * 4);
constexpr size_t OFF_XC = al(OFF_DEC + 16 * 132 * 64 * 4);
constexpr size_t OFF_WGU = al(OFF_XC + (size_t)MC * D * 4);
constexpr size_t OFF_WD = al(OFF_WGU + (size_t)2 * NGU * D * 2);
constexpr size_t OFF_WIN = al(OFF_WD + (size_t)2 * D * DFF * 2);
constexpr size_t OFF_WGATE = al(OFF_WIN + (size_t)NWIN * D * 2);
constexpr size_t OFF_WBR = al(OFF_WGATE + (size_t)3072 * D * 2);
constexpr size_t OFF_WOUT = al(OFF_WBR + (size_t)3 * D * 512 * 2);
constexpr size_t OFF_WUQ = al(OFF_WOUT + (size_t)D * D * 2);
constexpr size_t OFF_WUKV = al(OFF_WUQ + (size_t)768 * 384 * 2);
constexpr size_t OFF_H = al(OFF_WUKV + (size_t)1024 * 256 * 2);
constexpr size_t OFF_BIG = al(OFF_H + (size_t)MT * D * 2);
constexpr size_t OFF_YC = OFF_BIG + (size_t)MT * NZ * 2;
constexpr size_t OFF_Y = al(OFF_BIG + (size_t)MT * DFF * 2);
constexpr size_t OFF_YA = al(OFF_Y + (size_t)MT * D * 2);
constexpr size_t OFF_YB = al(OFF_YA + (size_t)MT * 512 * 2);
constexpr size_t OFF_Q = al(OFF_YB + (size_t)MT * 512 * 2);
constexpr size_t OFF_K = al(OFF_Q + (size_t)16 * NPOS * 96 * 2);
constexpr size_t OFF_VT = al(OFF_K + (size_t)16 * NPOS * 96 * 2);
constexpr size_t OFF_GVT = al(OFF_VT + (size_t)16 * 64 * NPOS * 2);
constexpr size_t WS_END = al(OFF_GVT + (size_t)8 * 128 * NPOS * 2);
static_assert((size_t)MT * NZ * 2 + (size_t)MT * 512 * 2 == (size_t)MT * DFF * 2, "YC fits the ACT tail");
static_assert((size_t)2 * 1024 * NPOS * 2 == (size_t)MT * D * 2 && (size_t)16 * 132 * 8192 * 2 == (size_t)MT * D * 2, "PT/ST alias Y");

struct Params {
    const float *x, *c, *ctx, *c_ctx, *w_mod, *b_mod, *norm_pre, *norm_post, *wg, *wu, *wd, *w_in, *gla_wdec, *gla_bdec, *gla_norm,
        *q_norm, *w_uq, *kv_norm, *w_ukv, *w_branch, *w_out;
    float* out;
    unsigned char* ws;
    int ph_lo, ph_hi, coop, pad;
};

DEVI int ltid() { int t = threadIdx.x; asm volatile("" : "+v"(t)); return t; }
DEVI int lbid() { int t = blockIdx.x; asm volatile("" : "+s"(t)); return t; }
DEVI unsigned f2bf(float f) { unsigned u = __float_as_uint(f); return (u + 0x7fffu + ((u >> 16) & 1u)) >> 16; }
DEVI float bf2f(unsigned h) { return __uint_as_float(h << 16); }
DEVI unsigned pk2(float lo, float hi) { unsigned r; asm("v_cvt_pk_bf16_f32 %0, %1, %2" : "=v"(r) : "v"(lo), "v"(hi)); return r; }
DEVI float bflo(unsigned u) { return __uint_as_float(u << 16); }
DEVI float bfhi(unsigned u) { return __uint_as_float(u & 0xffff0000u); }
DEVI float sigmoidf_(float x) { return 1.f / (1.f + __expf(-x)); }
DEVI float siluf_(float x) { return x / (1.f + __expf(-x)); }
DEVI float logsigmoidf_(float x) { return fminf(x, 0.f) - __logf(1.f + __expf(-fabsf(x))); }
DEVI v4u pack8_for_mfma(float a0, float a1, float a2, float a3, float a4, float a5, float a6, float a7) {
    unsigned r0, r1, r2, r3;
    asm("v_cvt_pk_bf16_f32 %0, %4, %5\n\tv_cvt_pk_bf16_f32 %1, %6, %7\n\tv_cvt_pk_bf16_f32 %2, %8, %9\n\tv_cvt_pk_bf16_f32 %3, %10, %11\n\ts_nop 1"
        : "=&v"(r0), "=&v"(r1), "=&v"(r2), "=&v"(r3)
        : "v"(a0), "v"(a1), "v"(a2), "v"(a3), "v"(a4), "v"(a5), "v"(a6), "v"(a7));
    return (v4u){r0, r1, r2, r3};
}
#define LDS_WAIT() asm volatile("s_waitcnt lgkmcnt(0)" ::: "memory")
#define VM_WAIT() asm volatile("s_waitcnt vmcnt(0)" ::: "memory")

DEVI void dsincos(double x, double& s, double& c) {
    const double hp = 1.5707963267948966192313216916398;
    double kd = rint(x / hp);
    double r = x - kd * hp;
    int k = ((int)kd) & 3;
    double r2 = r * r;
    double sn = r * (1.0 + r2 * (-1.0 / 6 + r2 * (1.0 / 120 + r2 * (-1.0 / 5040 + r2 * (1.0 / 362880 + r2 * (-1.0 / 39916800 + r2 * (1.0 / 6227020800.0)))))));
    double cs = 1.0 + r2 * (-0.5 + r2 * (1.0 / 24 + r2 * (-1.0 / 720 + r2 * (1.0 / 40320 + r2 * (-1.0 / 3628800 + r2 * (1.0 / 479001600.0 + r2 * (-1.0 / 87178291200.0)))))));
    if (k == 0) { s = sn; c = cs; } else if (k == 1) { s = cs; c = -sn; } else if (k == 2) { s = -sn; c = -cs; } else { s = -cs; c = sn; }
}

DEVI size_t boff(int row, int k, int K) { return ((size_t)(row >> 4) * (K >> 5) + (k >> 5)) * 512 + (row & 15) * 32 + (k & 31); }
DEVI int row_of_pos(int b, int pos) { return pos < SEQ ? b * SEQ + pos : ML + b * CTXL + (pos - SEQ); }

template <int MB, int NS, bool SWAP = false, bool BLK = true>
DEVI void gemm_ml(const bf16* __restrict__ A, int lda, const bf16* __restrict__ Bt, int ldb, int K, int row0, int col0,
                  unsigned char* smem, f32x4 (&acc)[MB][4]) {
    const int tid = ltid(), lane = tid & 63, wid = tid >> 6, wr = wid >> 1, wc = wid & 1, fr = lane & 15, fq = lane >> 4;
    constexpr int AROWS = 32 * MB, ABYTES = AROWS * 64, STG = ABYTES + 8192, NA = AROWS / 64, NL = NA + 2;
    const int r_ = tid >> 2, c_ = (tid & 3) * 8;
    const bf16* ap = BLK ? A + (size_t)((row0 >> 4) + (r_ >> 4)) * (lda >> 5) * 512 + (r_ & 15) * 32 + c_ : A + (size_t)(row0 + r_) * lda + c_;
    const bf16* bp = BLK ? Bt + (size_t)((col0 >> 4) + (r_ >> 4)) * (ldb >> 5) * 512 + (r_ & 15) * 32 + c_ : Bt + (size_t)(col0 + r_) * ldb + c_;
    const size_t a64 = BLK ? (size_t)4 * (lda >> 5) * 512 : (size_t)64 * lda;
    const size_t b64 = BLK ? (size_t)4 * (ldb >> 5) * 512 : (size_t)64 * ldb;
#define GSTAGE(buf, kk) do { unsigned char* sa_ = smem + (buf) * STG; const size_t ko_ = BLK ? (size_t)(kk) * 16 : (size_t)(kk); \
    _Pragma("unroll") for (int i_ = 0; i_ < NA; ++i_) __builtin_amdgcn_global_load_lds((const GAS unsigned*)(ap + i_ * a64 + ko_), (LAS unsigned*)(sa_ + tid * 16 + i_ * 4096), 16, 0, 0); \
    _Pragma("unroll") for (int i_ = 0; i_ < 2; ++i_) __builtin_amdgcn_global_load_lds((const GAS unsigned*)(bp + i_ * b64 + ko_), (LAS unsigned*)(sa_ + ABYTES + tid * 16 + i_ * 4096), 16, 0, 0); } while (0)
    const int nk = K >> 5;
    __syncthreads();
#pragma unroll
    for (int s0 = 0; s0 < NS - 1; ++s0) if (s0 < nk) GSTAGE(s0, s0 * 32);
    int buf = 0;
    for (int it = 0; it < nk; ++it) {
        if (NS >= 3 && it + 1 < nk) asm volatile("s_waitcnt vmcnt(%0)" ::"n"(NL) : "memory");
        else asm volatile("s_waitcnt vmcnt(0)" ::: "memory");
        asm volatile("" ::: "memory");
        __builtin_amdgcn_s_barrier();
        asm volatile("" ::: "memory");
        if (it + NS - 1 < nk) { int nb = buf + NS - 1; if (nb >= NS) nb -= NS; GSTAGE(nb, (it + NS - 1) * 32); }
        const unsigned char* SA = smem + buf * STG;
        const unsigned char* SB = SA + ABYTES;
        bf16x8 Bf[4], Af[MB];
#pragma unroll
        for (int n = 0; n < 4; ++n) Bf[n] = *(const bf16x8*)(SB + (wc * 64 + n * 16 + fr) * 64 + fq * 16);
#pragma unroll
        for (int m = 0; m < MB; ++m) Af[m] = *(const bf16x8*)(SA + (wr * (MB * 16) + m * 16 + fr) * 64 + fq * 16);
        __builtin_amdgcn_sched_barrier(0);
#pragma unroll
        for (int m = 0; m < MB; ++m)
#pragma unroll
            for (int n = 0; n < 4; ++n) {
                if (SWAP) acc[m][n] = __builtin_amdgcn_mfma_f32_16x16x32_bf16(Bf[n], Af[m], acc[m][n], 0, 0, 0);
                else acc[m][n] = __builtin_amdgcn_mfma_f32_16x16x32_bf16(Af[m], Bf[n], acc[m][n], 0, 0, 0);
            }
        __builtin_amdgcn_sched_barrier(0);
        buf = (buf == NS - 1) ? 0 : buf + 1;
    }
#undef GSTAGE
}
template <int MB>
DEVI void zero_acc(f32x4 (&acc)[MB][4]) {
#pragma unroll
    for (int m = 0; m < MB; ++m)
#pragma unroll
        for (int n = 0; n < 4; ++n) acc[m][n] = (f32x4){0.f, 0.f, 0.f, 0.f};
}
DEVI int xcd_slot() { const int G = gridDim.x, b = lbid(); return (G & 7) ? b : (b & 7) * (G >> 3) + (b >> 3); }
#define FOR_ITEMS(L, total) for (int L##_r = 0, L##_s = xcd_slot(), L; L##_r < (total); L##_r += gridDim.x) if ((L = L##_r + L##_s) < (total))
DEVI void tile_map(int L, int MTILES, int NT, int& tm, int& tn) {
    const int PH = (MTILES % 8 == 0) ? 8 : (MTILES % 6 == 0) ? 6 : 4;
    int p = L / (PH * NT), w = L - p * PH * NT;
    tn = w / PH; tm = p * PH + (w - tn * PH);
}

DEVI void transpose_item(const float* __restrict__ W, int ldsrc, int k0, int n0, const float* __restrict__ kscale, bf16* __restrict__ WT, int ldk,
                         int R0, float* scr, int lane, bool blk = true) {
    {
        const int kq = lane >> 3, n4 = (lane & 7) * 4;
        f32x4 v[8];
#pragma unroll
        for (int i = 0; i < 8; ++i) v[i] = *(const f32x4*)(W + (size_t)(k0 + i * 8 + kq) * ldsrc + n0 + n4);
#pragma unroll
        for (int i = 0; i < 8; ++i) {
            const int kk = i * 8 + kq;
            const float sc = kscale ? kscale[k0 + kk] : 1.f;
            float* d = scr + kk * 33 + n4;
            d[0] = v[i].x * sc; d[1] = v[i].y * sc; d[2] = v[i].z * sc; d[3] = v[i].w * sc;
        }
    }
    LDS_WAIT();
    __builtin_amdgcn_wave_barrier();
    const int c = lane & 7;
#pragma unroll
    for (int j = 0; j < 4; ++j) {
        const int n = (lane >> 3) + 8 * j;
        const float* s = scr + (8 * c) * 33 + n;
        v4u o;
        o.x = pk2(s[0], s[33]); o.y = pk2(s[66], s[99]); o.z = pk2(s[132], s[165]); o.w = pk2(s[198], s[231]);
        *(v4u*)(WT + (blk ? boff(R0 + n, k0 + 8 * c, ldk) : (size_t)(R0 + n) * ldk + k0 + 8 * c)) = o;
    }
    LDS_WAIT();
    __builtin_amdgcn_wave_barrier();
}

DEVI void transpose_dispatch(const Params& P, int l, int it, float* scr, int lane) {
    unsigned char* ws = P.ws;
    int r = it;
    if (r < 4 * 1408) {
        int jh = r / 1408; r -= jh * 1408;
        int j = jh >> 1, half = jh & 1;
        int kb = r / 88, nb = r - kb * 88, n0 = nb * 32;
        const float* src = (half ? P.wu : P.wg) + (size_t)(l * 2 + j) * D * DFF;
        int R0 = (n0 >> 6) * 128 + ((n0 >> 5) & 1) * 64 + half * 32;
        transpose_item(src, DFF, kb * 64, n0, nullptr, (bf16*)(ws + OFF_WGU) + (size_t)j * NGU * D, D, R0, scr, lane);
        return;
    }
    r -= 4 * 1408;
    if (r < 2 * 1408) {
        int j = r / 1408; r -= j * 1408;
        int kb = r >> 5, nb = r & 31;
        transpose_item(P.wd + (size_t)(l * 2 + j) * DFF * D, D, kb * 64, nb * 32, nullptr, (bf16*)(ws + OFF_WD) + (size_t)j * D * DFF, DFF, nb * 32, scr, lane);
        return;
    }
    r -= 2 * 1408;
    if (r < 2912) {
        int kb = r / 182, nb = r - kb * 182, n0 = nb * 32;
        bf16* dst = (bf16*)(ws + OFF_WIN);
        int R0;
        if (n0 < 1536) R0 = n0;
        else if (n0 < 1568) R0 = 2176;
        else if (n0 < 2080) return;
        else if (n0 < 2464) R0 = 1536 + (n0 - 2080);
        else if (n0 < 2720) R0 = 1920 + (n0 - 2464);
        else if (n0 < 2752) R0 = 2208;
        else { dst = (bf16*)(ws + OFF_WGATE); R0 = n0 - 2752; }
        transpose_item(P.w_in + (size_t)l * D * DIN, DIN, kb * 64, n0, nullptr, dst, D, R0, scr, lane);
        return;
    }
    r -= 2912;
    if (r < 768) {
        int i = r >> 8; r &= 255;
        int kb = r >> 5, nb = r & 31;
        transpose_item(P.w_branch + (size_t)(l * 3 + i) * 512 * D, D, kb * 64, nb * 32, nullptr, (bf16*)(ws + OFF_WBR) + (size_t)i * D * 512, 512, nb * 32, scr, lane);
        return;
    }
    r -= 768;
    if (r < 512) {
        int kb = r >> 5, nb = r & 31;
        transpose_item(P.w_out + (size_t)l * D * D, D, kb * 64, nb * 32, nullptr, (bf16*)(ws + OFF_WOUT), D, nb * 32, scr, lane);
        return;
    }
    r -= 512;
    if (r < 144) {
        int kb = r / 24, nb = r - kb * 24;
        transpose_item(P.w_uq + (size_t)l * 384 * 768, 768, kb * 64, nb * 32, P.q_norm + l * 384, (bf16*)(ws + OFF_WUQ), 384, nb * 32, scr, lane, false);
        return;
    }
    r -= 144;
    {
        int kb = r >> 5, nb = r & 31;
        transpose_item(P.w_ukv + (size_t)l * 256 * 1024, 1024, kb * 64, nb * 32, P.kv_norm + l * 256, (bf16*)(ws + OFF_WUKV), 256, nb * 32, scr, lane, false);
    }
}
constexpr int N_TR_WAVE_ITEMS = 6 * 1408 + 2912 + 768 + 512 + 144 + 128;
constexpr int N_TR_BLOCK_ITEMS = N_TR_WAVE_ITEMS / 4;
static_assert(N_TR_WAVE_ITEMS % 4 == 0, "");

DEVI void fold_item(const Params& P, int l, int it, unsigned char* smem) {
    const int tid = ltid();
    const int g = it >> 4, k0 = (it & 15) * 64;
    float* Wt = (float*)smem;
    float* ct = Wt + 64 * 128;
    __syncthreads();
    const float* src = P.w_in + (size_t)l * D * DIN + 1568 + g * 128;
    for (int idx = tid; idx < 64 * 128; idx += NTHREADS) { int kk = idx >> 7, cc = idx & 127; Wt[idx] = src[(size_t)(k0 + kk) * DIN + cc]; }
    if (tid < 128) { double s, c; dsincos(6.283185307179586476925286766559 * (double)tid / 128.0, s, c); ct[tid] = (float)c; ct[128 + tid] = (float)s; }
    __syncthreads();
    const int k2 = tid & 127, part = tid >> 7;
    bf16* dst = (bf16*)(P.ws + OFF_WIN) + boff(2304 + part * 512 + g * 128 + k2, k0, D);
    for (int kk = 0; kk < 64; kk += 8) {
        float a[8];
#pragma unroll
        for (int u = 0; u < 8; ++u) a[u] = 0.f;
        for (int c = 0; c < 128; ++c) {
            int m = (c * k2) & 127;
            float tw = part ? -ct[128 + m] : ct[m];
#pragma unroll
            for (int u = 0; u < 8; ++u) a[u] += Wt[(kk + u) * 128 + c] * tw;
        }
        v4u o; o.x = pk2(a[0], a[1]); o.y = pk2(a[2], a[3]); o.z = pk2(a[4], a[5]); o.w = pk2(a[6], a[7]);
        *(v4u*)(dst + (kk >> 5) * 512 + (kk & 31)) = o;
    }
}

DEVI void mod_item(const Params& P, int it, unsigned char* smem) {
    const int tid = ltid(), lane = tid & 63, w = tid >> 6;
    const int l = it / 144, n0 = (it - l * 144) * 64;
    float* sc = (float*)smem;
    float* red = sc + 3 * 1024;
    __syncthreads();
    for (int i = tid; i < 3 * 1024; i += NTHREADS) {
        int r = i >> 10, k = i & 1023;
        float v = r < 2 ? P.c[r * D + k] : P.c_ctx[k];
        sc[i] = siluf_(v);
    }
    __syncthreads();
    const float* wsrc = P.w_mod + (size_t)l * D * NMOD + n0 + lane;
    float a0 = 0.f, a1 = 0.f, a2 = 0.f;
#pragma unroll 8
    for (int k = w * 256; k < w * 256 + 256; ++k) {
        float wv = wsrc[(size_t)k * NMOD];
        a0 += sc[k] * wv; a1 += sc[1024 + k] * wv; a2 += sc[2048 + k] * wv;
    }
    red[(w * 3 + 0) * 64 + lane] = a0; red[(w * 3 + 1) * 64 + lane] = a1; red[(w * 3 + 2) * 64 + lane] = a2;
    __syncthreads();
    if (tid < 192) {
        int r = tid >> 6;
        float s = red[(0 * 3 + r) * 64 + lane] + red[(1 * 3 + r) * 64 + lane] + red[(2 * 3 + r) * 64 + lane] + red[(3 * 3 + r) * 64 + lane];
        float* MOD = (float*)(P.ws + OFF_MOD);
        MOD[(size_t)(l * 3 + r) * NMOD + n0 + lane] = s + P.b_mod[(size_t)l * NMOD + n0 + lane];
    }
}

DEVI void tables_item(const Params& P) {
    const int tid = ltid();
    float* RT = (float*)(P.ws + OFF_ROPE);
    float* TW = (float*)(P.ws + OFF_TW);
    for (int i = tid; i < 1024; i += NTHREADS) {
        int p = i >> 3, f = i & 7;
        float fv = f == 0 ? 1.0f : f == 1 ? 0.31622776601683794f : f == 2 ? 0.1f : f == 3 ? 0.03162277660168379f : f == 4 ? 0.01f : f == 5 ? 0.0031622776601683794f : f == 6 ? 0.001f : 0.00031622776601683794f;
        float ang = (float)p * fv;
        double s, c; dsincos((double)ang, s, c);
        RT[i * 2] = (float)c; RT[i * 2 + 1] = (float)s;
    }
    for (int m = tid; m < 4096; m += NTHREADS) {
        double s, c; dsincos(6.283185307179586476925286766559 * (double)m / 8192.0, s, c);
        TW[m * 2] = (float)c; TW[m * 2 + 1] = (float)s;
    }
}

DEVI void prep_phase(const Params& P, int l, bool first, unsigned char* smem) {
    const int n_mod = first ? 288 : 0, n_tab = first ? 1 : 0, n_fold = 64;
    const int total = n_mod + n_tab + n_fold + N_TR_BLOCK_ITEMS;
    const int lane = ltid() & 63, w = ltid() >> 6;
    FOR_ITEMS(it, total) {
        int r = it;
        if (r < n_mod) { mod_item(P, r, smem); continue; }
        r -= n_mod;
        if (r < n_tab) { tables_item(P); continue; }
        r -= n_tab;
        if (r < n_fold) { fold_item(P, l, r, smem); continue; }
        r -= n_fold;
        __syncthreads();
        transpose_dispatch(P, l, r * 4 + w, (float*)smem + w * (64 * 33), lane);
    }
}

DEVI void norm_phase(const Params& P, int nrows, bool first_x, bool has_res, float rscale, const float* g_post, const float* mod_res  , int gate_chunk,
                     bool has_h, const float* g_pre, const float* mod_h, int shift_chunk) {
    const int lane = ltid() & 63, w = ltid() >> 6;
    const bf16* Y = (const bf16*)(P.ws + OFF_Y);
    bf16* H = (bf16*)(P.ws + OFF_H);
    float* XC = (float*)(P.ws + OFF_XC);
    f32x4 cr[4], ch[4], cs[4];
    int cur = -1;
    for (int r = lbid() * 4 + w; r < nrows; r += gridDim.x * 4) {
        const bool lat = r < ML;
        const int mrow = lat ? (r >> 13) : 2;
        if (mrow != cur) {
            cur = mrow;
#pragma unroll
            for (int j = 0; j < 4; ++j) {
                const int c = 4 * lane + 256 * j;
                if (has_res) {
                    f32x4 gp = *(const f32x4*)(g_post + c);
                    f32x4 gt = *(const f32x4*)(mod_res + (size_t)mrow * NMOD + gate_chunk * D + c);
                    cr[j] = (f32x4){gt.x * gp.x * rscale, gt.y * gp.y * rscale, gt.z * gp.z * rscale, gt.w * gp.w * rscale};
                }
                if (has_h) {
                    f32x4 gp = *(const f32x4*)(g_pre + c);
                    f32x4 sh = *(const f32x4*)(mod_h + (size_t)mrow * NMOD + shift_chunk * D + c);
                    f32x4 sc = *(const f32x4*)(mod_h + (size_t)mrow * NMOD + (shift_chunk + 1) * D + c);
                    ch[j] = (f32x4){gp.x * (1.f + sc.x), gp.y * (1.f + sc.y), gp.z * (1.f + sc.z), gp.w * (1.f + sc.w)};
                    cs[j] = sh;
                }
            }
        }
        const float* xin = lat ? ((first_x ? P.x : P.out) + (size_t)r * D) : ((first_x ? P.ctx : XC) + (size_t)(r - ML) * D);
        float* xout = lat ? (P.out + (size_t)r * D) : (XC + (size_t)(r - ML) * D);
        f32x4 v[4];
#pragma unroll
        for (int j = 0; j < 4; ++j) v[j] = *(const f32x4*)(xin + 4 * lane + 256 * j);
        if (has_res) {
            f32x4 y[4];
            float ss = 0.f;
#pragma unroll
            for (int j = 0; j < 4; ++j) {
                v2u u = *(const v2u*)(Y + (size_t)r * D + 4 * lane + 256 * j);
                y[j] = (f32x4){bflo(u.x), bfhi(u.x), bflo(u.y), bfhi(u.y)};
                ss += y[j].x * y[j].x + y[j].y * y[j].y + y[j].z * y[j].z + y[j].w * y[j].w;
            }
#pragma unroll
            for (int o = 1; o < 64; o <<= 1) ss += __shfl_xor(ss, o);
            const float rs = rsqrtf(ss * (1.f / D) + EPS);
#pragma unroll
            for (int j = 0; j < 4; ++j) {
                v[j].x += cr[j].x * (y[j].x * rs); v[j].y += cr[j].y * (y[j].y * rs);
                v[j].z += cr[j].z * (y[j].z * rs); v[j].w += cr[j].w * (y[j].w * rs);
                *(f32x4*)(xout + 4 * lane + 256 * j) = v[j];
            }
        }
        if (has_h) {
            float ss = 0.f;
#pragma unroll
            for (int j = 0; j < 4; ++j) ss += v[j].x * v[j].x + v[j].y * v[j].y + v[j].z * v[j].z + v[j].w * v[j].w;
#pragma unroll
            for (int o = 1; o < 64; o <<= 1) ss += __shfl_xor(ss, o);
            const float rs = rsqrtf(ss * (1.f / D) + EPS);
#pragma unroll
            for (int j = 0; j < 4; ++j) {
                v2u o;
                o.x = pk2(v[j].x * rs * ch[j].x + cs[j].x, v[j].y * rs * ch[j].y + cs[j].y);
                o.y = pk2(v[j].z * rs * ch[j].z + cs[j].z, v[j].w * rs * ch[j].w + cs[j].w);
                *(v2u*)(H + boff(r, 4 * lane + 256 * j, D)) = o;
            }
        }
    }
}

#define EPI_COORDS const int tid = ltid(), lane = tid & 63, wid = tid >> 6, wr = wid >> 1, wc = wid & 1, fr = lane & 15, fq = lane >> 4; (void)tid; (void)wr; (void)wc; (void)fr; (void)fq;

DEVI void gemm_gu_phase(const Params& P, int j, int mtiles, unsigned char* smem) {
    EPI_COORDS
    const bf16* A = (const bf16*)(P.ws + OFF_H);
    const bf16* Bt = (const bf16*)(P.ws + OFF_WGU) + (size_t)j * NGU * D;
    bf16* ACT = (bf16*)(P.ws + OFF_BIG);
    const int NT = NGU / 128, total = mtiles * NT;
    FOR_ITEMS(L, total) {
        int tm, tn; tile_map(L, mtiles, NT, tm, tn);
        f32x4 acc[8][4]; zero_acc<8>(acc);
        gemm_ml<8, 3, true>(A, D, Bt, D, D, tm * 256, tn * 128, smem, acc);
#pragma unroll
        for (int m = 0; m < 8; ++m)
#pragma unroll
            for (int n = 0; n < 2; ++n) {
                int row = tm * 256 + wr * 128 + m * 16 + fr;
                int col = tn * 64 + wc * 32 + n * 16 + fq * 4;
                v2u o;
                o.x = pk2(siluf_(acc[m][n][0]) * acc[m][n + 2][0], siluf_(acc[m][n][1]) * acc[m][n + 2][1]);
                o.y = pk2(siluf_(acc[m][n][2]) * acc[m][n + 2][2], siluf_(acc[m][n][3]) * acc[m][n + 2][3]);
                *(v2u*)(ACT + boff(row, col, DFF)) = o;
            }
    }
}
template <int MB>
DEVI void plain_tile(const bf16* A, int lda, const bf16* Bt, int K, bf16* C, int ldc, int row0, int col0, unsigned char* smem) {
    EPI_COORDS
    f32x4 acc[MB][4]; zero_acc<MB>(acc);
    gemm_ml<MB, 3, true>(A, lda, Bt, K, K, row0, col0, smem, acc);
#pragma unroll
    for (int m = 0; m < MB; ++m)
#pragma unroll
        for (int n = 0; n < 4; ++n) {
            int row = row0 + wr * (MB * 16) + m * 16 + fr;
            int col = col0 + wc * 64 + n * 16 + fq * 4;
            v2u o; o.x = pk2(acc[m][n][0], acc[m][n][1]); o.y = pk2(acc[m][n][2], acc[m][n][3]);
            *(v2u*)(C + (size_t)row * ldc + col) = o;
        }
}
DEVI void gemm_plain_phase(const bf16* A, int lda, const bf16* Bt, int K, bf16* C, int ldc, int rows_big, int rows_small, unsigned char* smem) {
    const int NT = 8, mtb = rows_big / 256, nbig = mtb * NT, total = nbig + (rows_small / 64) * NT;
    FOR_ITEMS(L, total) {
        if (L < nbig) { int tm, tn; tile_map(L, mtb, NT, tm, tn); plain_tile<8>(A, lda, Bt, K, C, ldc, tm * 256, tn * 128, smem); }
        else { int r = L - nbig; plain_tile<2>(A, lda, Bt, K, C, ldc, rows_big + (r >> 3) * 64, (r & 7) * 128, smem); }
    }
}
DEVI float rope_apply(float v, int fr, int p, const float* RT) {
    asm volatile("" : "+v"(p));
    float partner = __shfl_xor(v, 8);
    const float cs = RT[(p * 8 + (fr & 7)) * 2], sn = RT[(p * 8 + (fr & 7)) * 2 + 1];
    return (fr & 8) ? (v * cs + partner * sn) : (v * cs - partner * sn);
}
DEVI void gemm_win_phase(const Params& P, unsigned char* smem) {
    EPI_COORDS
    const bf16* A = (const bf16*)(P.ws + OFF_H);
    const bf16* Bt = (const bf16*)(P.ws + OFF_WIN);
    bf16* Z = (bf16*)(P.ws + OFF_BIG);
    bf16* PT = (bf16*)(P.ws + OFF_Y);
    bf16* KF = (bf16*)(P.ws + OFF_K);
    const float* RT = (const float*)(P.ws + OFF_ROPE);
    const int NT = NWIN / 128, MTL = MT / 256, total = MTL * NT;
    FOR_ITEMS(L, total) {
        int tm, tn; tile_map(L, MTL, NT, tm, tn);
        f32x4 acc[8][4]; zero_acc<8>(acc);
        gemm_ml<8, 3>(A, D, Bt, D, D, tm * 256, tn * 128, smem, acc);
        const int row0 = tm * 256;
        const bool lat = row0 < ML;
        const int b = lat ? (row0 >> 13) : ((row0 - ML) >> 8);
        const int pos0 = lat ? (row0 & (SEQ - 1)) : (SEQ + ((row0 - ML) & (CTXL - 1)));
        if (tn >= 4 && tn < 8) {
            bf16* GVT = (bf16*)(P.ws + OFF_GVT);
#pragma unroll
            for (int m = 0; m < 8; ++m)
#pragma unroll
                for (int n = 0; n < 4; ++n) {
                    int e = wc * 64 + n * 16 + fr;
                    int pos = pos0 + wr * 128 + m * 16 + fq * 4;
                    v2u o; o.x = pk2(acc[m][n][0], acc[m][n][1]); o.y = pk2(acc[m][n][2], acc[m][n][3]);
                    *(v2u*)(GVT + ((size_t)((b * 4 + tn - 4) * 128 + e)) * NPOS + pos) = o;
                }
        } else if (tn < 17) {
#pragma unroll
            for (int m = 0; m < 8; ++m)
#pragma unroll
                for (int n = 0; n < 4; ++n)
#pragma unroll
                    for (int jj = 0; jj < 4; ++jj) {
                        int row = row0 + wr * 128 + m * 16 + fq * 4 + jj;
                        int col = tn * 128 + wc * 64 + n * 16 + fr;
                        Z[(size_t)row * NZ + col] = (bf16)f2bf(acc[m][n][jj]);
                    }
        } else if (tn == 17) {
            if (wc == 0) {
#pragma unroll
                for (int m = 0; m < 8; ++m)
#pragma unroll
                    for (int jj = 0; jj < 4; ++jj) {
                        int lr = wr * 128 + m * 16 + fq * 4 + jj;
                        int row = row0 + lr, pos = pos0 + lr;
#pragma unroll
                        for (int n = 0; n < 2; ++n) Z[(size_t)row * NZ + 2176 + n * 16 + fr] = (bf16)f2bf(acc[m][n][jj]);
                        float v2 = acc[m][2][jj], v3 = acc[m][3][jj];
                        if (lat) { v2 = rope_apply(v2, fr, pos >> 6, RT); v3 = rope_apply(v3, fr, pos & 63, RT); }
                        bf16 h2 = (bf16)f2bf(v2), h3 = (bf16)f2bf(v3);
#pragma unroll
                        for (int h = 0; h < 8; ++h) {
                            bf16* kd = KF + ((size_t)(b * 8 + h) * NPOS + pos) * 96 + 64;
                            kd[fr] = h2; kd[16 + fr] = h3;
                        }
                    }
            }
        } else {
            const int c0 = (tn - 18) * 128 + wc * 64;
#pragma unroll
            for (int m = 0; m < 8; ++m)
#pragma unroll
                for (int n = 0; n < 4; ++n) {
                    int c = c0 + n * 16 + fr;
                    int pos = pos0 + wr * 128 + m * 16 + fq * 4;
                    v2u o; o.x = pk2(acc[m][n][0], acc[m][n][1]); o.y = pk2(acc[m][n][2], acc[m][n][3]);
                    *(v2u*)(PT + ((size_t)(b * 1024 + c)) * NPOS + pos) = o;
                }
        }
    }
}

DEVI void row_rms(const bf16* A, int lda, int K, int row0, float* rsc) {
    const int tid = ltid();
    const int r = tid >> 1, hf = tid & 1;
    const bf16* p = A + (size_t)(row0 + r) * lda + hf * (K / 2);
    float ss = 0.f;
    for (int k = 0; k < K / 2; k += 8) {
        v4u u = *(const v4u*)(p + k);
        float a;
        a = bflo(u.x); ss += a * a; a = bfhi(u.x); ss += a * a; a = bflo(u.y); ss += a * a; a = bfhi(u.y); ss += a * a;
        a = bflo(u.z); ss += a * a; a = bfhi(u.z); ss += a * a; a = bflo(u.w); ss += a * a; a = bfhi(u.w); ss += a * a;
    }
    ss += __shfl_xor(ss, 1);
    if (hf == 0) rsc[r] = rsqrtf(ss / (float)K + EPS);
}

DEVI void mla_q_tile(const Params& P, int tm, int tn, unsigned char* smem) {
    EPI_COORDS
    const bf16* Z = (const bf16*)(P.ws + OFF_BIG);
    bf16* Q = (bf16*)(P.ws + OFF_Q);
    const float* RT = (const float*)(P.ws + OFF_ROPE);
    float* rsc = (float*)(smem + 49152);
    const int row0 = tm * 128;
    __syncthreads();
    row_rms(Z + 1536, NZ, 384, row0, rsc);
    f32x4 acc[4][4]; zero_acc<4>(acc);
    gemm_ml<4, 3, false, false>(Z + 1536, NZ, (const bf16*)(P.ws + OFF_WUQ), 384, 384, row0, tn * 128, smem, acc);
    const bool lat = row0 < ML;
    const int b = lat ? (row0 >> 13) : ((row0 - ML) >> 8);
    const int pos0 = lat ? (row0 & (SEQ - 1)) : (SEQ + ((row0 - ML) & (CTXL - 1)));
    const float qs = 0.10206207261596575f * 1.4426950408889634f;
#pragma unroll
    for (int n = 0; n < 4; ++n) {
        const int c16 = tn * 128 + wc * 64 + n * 16;
        const int h = c16 / 96, d0 = c16 - h * 96;
#pragma unroll
        for (int m = 0; m < 4; ++m)
#pragma unroll
            for (int jj = 0; jj < 4; ++jj) {
                int lr = wr * 64 + m * 16 + fq * 4 + jj;
                int pos = pos0 + lr;
                float v = acc[m][n][jj] * rsc[lr];
                if (lat && d0 >= 64) v = rope_apply(v, fr, d0 == 64 ? (pos >> 6) : (pos & 63), RT);
                Q[((size_t)(b * 8 + h) * NPOS + pos) * 96 + d0 + fr] = (bf16)f2bf(v * qs);
            }
    }
}
DEVI void mla_kv_tile(const Params& P, int tm, int tn, unsigned char* smem) {
    EPI_COORDS
    const bf16* Z = (const bf16*)(P.ws + OFF_BIG);
    bf16* KF = (bf16*)(P.ws + OFF_K);
    bf16* VT = (bf16*)(P.ws + OFF_VT);
    float* rsc = (float*)(smem + 49152);
    const int row0 = tm * 128;
    __syncthreads();
    row_rms(Z + 1920, NZ, 256, row0, rsc);
    f32x4 acc[4][4]; zero_acc<4>(acc);
    gemm_ml<4, 3, false, false>(Z + 1920, NZ, (const bf16*)(P.ws + OFF_WUKV), 256, 256, row0, tn * 128, smem, acc);
    const bool lat = row0 < ML;
    const int b = lat ? (row0 >> 13) : ((row0 - ML) >> 8);
    const int pos0 = lat ? (row0 & (SEQ - 1)) : (SEQ + ((row0 - ML) & (CTXL - 1)));
    const int h = tn;
    if (wc == 0) {
#pragma unroll
        for (int m = 0; m < 4; ++m)
#pragma unroll
            for (int n = 0; n < 4; ++n)
#pragma unroll
                for (int jj = 0; jj < 4; ++jj) {
                    int lr = wr * 64 + m * 16 + fq * 4 + jj;
                    KF[((size_t)(b * 8 + h) * NPOS + pos0 + lr) * 96 + n * 16 + fr] = (bf16)f2bf(acc[m][n][jj] * rsc[lr]);
                }
    } else {
#pragma unroll
        for (int m = 0; m < 4; ++m)
#pragma unroll
            for (int n = 0; n < 4; ++n) {
                int lr = wr * 64 + m * 16 + fq * 4;
                v2u o; o.x = pk2(acc[m][n][0] * rsc[lr], acc[m][n][1] * rsc[lr + 1]); o.y = pk2(acc[m][n][2] * rsc[lr + 2], acc[m][n][3] * rsc[lr + 3]);
                *(v2u*)(VT + ((size_t)(b * 8 + h) * 64 + n * 16 + fr) * NPOS + pos0 + lr) = o;
            }
    }
}

DEVI void fft_item(const bf16* re_src, const bf16* im_src, int N, bf16* dst, int dst_stride, float scale, const float* TW, unsigned char* smem) {
    const int tid = ltid();
    float* re = (float*)smem;
    float* im = re + 8192;
    __syncthreads();
    for (int i = tid; i < N / 8; i += NTHREADS) {
        v4u a = *(const v4u*)(re_src + i * 8), b = *(const v4u*)(im_src + i * 8);
        float* r = re + i * 8; float* q = im + i * 8;
        r[0] = bflo(a.x); r[1] = bfhi(a.x); r[2] = bflo(a.y); r[3] = bfhi(a.y); r[4] = bflo(a.z); r[5] = bfhi(a.z); r[6] = bflo(a.w); r[7] = bfhi(a.w);
        q[0] = bflo(b.x); q[1] = bfhi(b.x); q[2] = bflo(b.y); q[3] = bfhi(b.y); q[4] = bflo(b.z); q[5] = bfhi(b.z); q[6] = bflo(b.w); q[7] = bfhi(b.w);
    }
    __syncthreads();
    const int t4 = N >> 2;
    int p = 1;
    for (; p * 4 <= N; p <<= 2) {
        float xr[8][4], xi[8][4];
#pragma unroll
        for (int u = 0; u < 8; ++u) {
            const int i = tid + NTHREADS * u;
#pragma unroll
            for (int r = 0; r < 4; ++r) {
                if (i < t4) { xr[u][r] = re[i + r * t4]; xi[u][r] = im[i + r * t4]; }
                else { xr[u][r] = 0.f; xi[u][r] = 0.f; }
            }
        }
        __syncthreads();
        const float inv4p = 0.25f / (float)p;
        const bool hoist = (p <= NTHREADS);
        const float rev_h = (float)(tid & (p - 1)) * inv4p;
        const float c_h = __builtin_amdgcn_cosf(rev_h), s_h = __builtin_amdgcn_sinf(rev_h);
#pragma unroll
        for (int u = 0; u < 8; ++u) {
            const int i = tid + NTHREADS * u;
            if (i < t4) {
                const int k = i & (p - 1);
                const int j = ((i - k) << 2) + k;
                float w1r = c_h, w1i = -s_h;
                if (!hoist) { const float rev = (float)k * inv4p; w1r = __builtin_amdgcn_cosf(rev); w1i = -__builtin_amdgcn_sinf(rev); }
                const float w2r = w1r * w1r - w1i * w1i, w2i = 2.f * w1r * w1i;
                const float w3r = w2r * w1r - w2i * w1i, w3i = w2r * w1i + w2i * w1r;
                const float u0r = xr[u][0], u0i = xi[u][0];
                const float u1r = xr[u][1] * w1r - xi[u][1] * w1i, u1i = xr[u][1] * w1i + xi[u][1] * w1r;
                const float u2r = xr[u][2] * w2r - xi[u][2] * w2i, u2i = xr[u][2] * w2i + xi[u][2] * w2r;
                const float u3r = xr[u][3] * w3r - xi[u][3] * w3i, u3i = xr[u][3] * w3i + xi[u][3] * w3r;
                const float v0r = u0r + u2r, v0i = u0i + u2i, v1r = u0r - u2r, v1i = u0i - u2i;
                const float v2r = u1r + u3r, v2i = u1i + u3i, dr = u1r - u3r, di = u1i - u3i;
                const float v3r = di, v3i = -dr;
                re[j] = v0r + v2r;         im[j] = v0i + v2i;
                re[j + p] = v1r + v3r;     im[j + p] = v1i + v3i;
                re[j + 2 * p] = v0r - v2r; im[j + 2 * p] = v0i - v2i;
                re[j + 3 * p] = v1r - v3r; im[j + 3 * p] = v1i - v3i;
            }
        }
        __syncthreads();
    }
    if (p < N) {
        const int half = N >> 1;
        float ar[16], ai[16], br[16], bi[16];
#pragma unroll
        for (int u = 0; u < 16; ++u) {
            int i = tid + NTHREADS * u;
            if (i < half) { ar[u] = re[i]; ai[u] = im[i]; br[u] = re[i + half]; bi[u] = im[i + half]; }
            else { ar[u] = 0.f; ai[u] = 0.f; br[u] = 0.f; bi[u] = 0.f; }
        }
        __syncthreads();
        const float inv2p = 0.5f / (float)p;
#pragma unroll
        for (int u = 0; u < 16; ++u) {
            int i = tid + NTHREADS * u;
            if (i < half) {
                int k = i & (p - 1);
                int j = ((i - k) << 1) + k;
                const float rev = (float)k * inv2p;
                const float c = __builtin_amdgcn_cosf(rev), sn = __builtin_amdgcn_sinf(rev);
                float xr2 = br[u] * c + bi[u] * sn, xi2 = bi[u] * c - br[u] * sn;
                re[j] = ar[u] + xr2; im[j] = ai[u] + xi2; re[j + p] = ar[u] - xr2; im[j + p] = ai[u] - xi2;
            }
        }
        __syncthreads();
    }
    (void)dst_stride;
    for (int i = tid * 8; i < N; i += NTHREADS * 8) {
        const float* r = re + i;
        v4u o; o.x = pk2(r[0] * scale, r[1] * scale); o.y = pk2(r[2] * scale, r[3] * scale); o.z = pk2(r[4] * scale, r[5] * scale); o.w = pk2(r[6] * scale, r[7] * scale);
        *(v4u*)(dst + i) = o;
    }
}

DEVI void ybt_transpose_item(const Params& P, int it, unsigned char* smem) {
    const int tid = ltid();
    int b, pos0, c0;
    if (it < 2048) { b = it >> 10; pos0 = ((it >> 3) & 127) * 64; c0 = (it & 7) * 64; }
    else { int r = it - 2048; b = r >> 5; pos0 = SEQ + ((r >> 3) & 3) * 64; c0 = (r & 7) * 64; }
    const bf16* PT = (const bf16*)(P.ws + OFF_Y);
    bf16* YB = (bf16*)(P.ws + OFF_YB);
    bf16* T = (bf16*)smem;
    __syncthreads();
#pragma unroll
    for (int i = 0; i < 2; ++i) {
        int ch = tid + NTHREADS * i;
        int c = ch >> 3, p8 = (ch & 7) * 8;
        v4u u = *(const v4u*)(PT + ((size_t)(b * 1024 + c0 + c)) * NPOS + pos0 + p8);
        T[(p8 + 0) * 72 + c] = (bf16)(u.x & 0xffff); T[(p8 + 1) * 72 + c] = (bf16)(u.x >> 16);
        T[(p8 + 2) * 72 + c] = (bf16)(u.y & 0xffff); T[(p8 + 3) * 72 + c] = (bf16)(u.y >> 16);
        T[(p8 + 4) * 72 + c] = (bf16)(u.z & 0xffff); T[(p8 + 5) * 72 + c] = (bf16)(u.z >> 16);
        T[(p8 + 6) * 72 + c] = (bf16)(u.w & 0xffff); T[(p8 + 7) * 72 + c] = (bf16)(u.w >> 16);
    }
    __syncthreads();
#pragma unroll
    for (int i = 0; i < 2; ++i) {
        int ch = tid + NTHREADS * i;
        int p = ch >> 3, c8 = (ch & 7) * 8;
        v4u u = *(const v4u*)(T + p * 72 + c8);
        *(v4u*)(YB + boff(row_of_pos(b, pos0 + p), c0 + c8, 512)) = u;
    }
}


template <int MB, int NBk>
DEVI void wave_mma(const bf16* As, int sa, const bf16* Bs, int sb, int K, f32x4 (&acc)[MB][NBk]) {
    const int lane = ltid() & 63, fr = lane & 15, fq = lane >> 4;
    for (int k = 0; k < K; k += 32) {
        bf16x8 a[MB], b[NBk];
#pragma unroll
        for (int m = 0; m < MB; ++m) a[m] = *(const bf16x8*)(As + (m * 16 + fr) * sa + k + fq * 8);
#pragma unroll
        for (int n = 0; n < NBk; ++n) b[n] = *(const bf16x8*)(Bs + (n * 16 + fr) * sb + k + fq * 8);
#pragma unroll
        for (int m = 0; m < MB; ++m)
#pragma unroll
            for (int n = 0; n < NBk; ++n) acc[m][n] = __builtin_amdgcn_mfma_f32_16x16x32_bf16(a[m], b[n], acc[m][n], 0, 0, 0);
    }
}

DEVI int gla_row_base(int b, int dir, int cp) {
    if (cp < 4) { int c = dir ? 3 - cp : cp; return ML + b * CTXL + c * 64; }
    int c = dir ? 131 - cp : cp - 4;
    return b * SEQ + c * 64;
}
DEVI void gla_cumsum(const Params& P, int l, const bf16* Z, int row0, int h, int dir, float* cum, float* abuf) {
    const int tid = ltid();
    for (int i = tid; i < 64 * 16; i += NTHREADS) { int t = i >> 4, r = i & 15; abuf[i] = bf2f(Z[(size_t)(row0 + t) * NZ + 2176 + dir * 16 + r]); }
    __syncthreads();
    const int d = tid & 63, q = tid >> 6;
    float* qtot = abuf + 1024;
    {
        const float* wd = P.gla_wdec + ((size_t)(l * 2 + dir) * 16) * 256 + h * 64 + d;
        float w[16];
#pragma unroll
        for (int r = 0; r < 16; ++r) w[r] = wd[r * 256];
        const float bb = P.gla_bdec[(l * 2 + dir) * 256 + h * 64 + d];
        float run = 0.f;
#pragma unroll 4
        for (int tt = 0; tt < 16; ++tt) {
            const int t = q * 16 + (dir ? 15 - tt : tt);
            const f32x4* ar = (const f32x4*)(abuf + t * 16);
            f32x4 a0 = ar[0], a1 = ar[1], a2 = ar[2], a3 = ar[3];
            float x = bb + a0.x * w[0] + a0.y * w[1] + a0.z * w[2] + a0.w * w[3] + a1.x * w[4] + a1.y * w[5] + a1.z * w[6] + a1.w * w[7]
                      + a2.x * w[8] + a2.y * w[9] + a2.z * w[10] + a2.w * w[11] + a3.x * w[12] + a3.y * w[13] + a3.z * w[14] + a3.w * w[15];
            run += logsigmoidf_(x) * (1.f / 16.f);
            cum[t * 64 + d] = run;
        }
        qtot[q * 64 + d] = run;
    }
    __syncthreads();
    {
        float off = 0.f;
        if (dir == 0) { for (int qq = 0; qq < q; ++qq) off += qtot[qq * 64 + d]; }
        else { for (int qq = 3; qq > q; --qq) off += qtot[qq * 64 + d]; }
#pragma unroll 4
        for (int tt = 0; tt < 16; ++tt) cum[(q * 16 + tt) * 64 + d] += off;
    }
    __syncthreads();
}
constexpr int GS = 72;
DEVI void gla_load_vt(const Params& P, int b, int h, int pos0, bf16* VTs) {
    const int tid = ltid();
    const bf16* G = (const bf16*)(P.ws + OFF_GVT) + (size_t)((b * 4 + h) * 128) * NPOS + pos0;
#pragma unroll
    for (int i = 0; i < 4; ++i) {
        int c = tid + NTHREADS * i;
        int e = c >> 3, part = c & 7;
        *(v4u*)(VTs + e * GS + part * 8) = *(const v4u*)(G + (size_t)e * NPOS + part * 8);
    }
}
DEVI void gla_local_item(const Params& P, int l, int it, unsigned char* smem) {
    const int tid = ltid(), lane = tid & 63, w = tid >> 6, fr = lane & 15, fq = lane >> 4;
    const int chain = it / 132, cp = it - chain * 132;
    const int b = chain >> 3, h = (chain >> 1) & 3, dir = chain & 1;
    const int row0 = gla_row_base(b, dir, cp);
    const bf16* Z = (const bf16*)(P.ws + OFF_BIG);
    float* cum = (float*)smem;
    bf16* VTs = (bf16*)(smem + 16384);
    bf16* KTs = (bf16*)(smem + 16384 + 128 * GS * 2);
    float* abuf = (float*)(smem + 16384 + 192 * GS * 2);
    __syncthreads();
    gla_cumsum(P, l, Z, row0, h, dir, cum, abuf);
    gla_load_vt(P, b, h, row0 < ML ? (row0 & (SEQ - 1)) : SEQ + ((row0 - ML) & (CTXL - 1)), VTs);
    const int tl = dir ? 0 : 63;
#pragma unroll
    for (int i = 0; i < 2; ++i) {
        int c = tid + NTHREADS * i;
        int s = c >> 3, d0 = (c & 7) * 8;
        v4u u = *(const v4u*)(Z + (size_t)(row0 + s) * NZ + 256 + h * 64 + d0);
        float kv[8] = {bflo(u.x), bfhi(u.x), bflo(u.y), bfhi(u.y), bflo(u.z), bfhi(u.z), bflo(u.w), bfhi(u.w)};
#pragma unroll
        for (int q = 0; q < 8; ++q) KTs[(d0 + q) * GS + s] = (bf16)f2bf(kv[q] * __expf(cum[tl * 64 + d0 + q] - cum[s * 64 + d0 + q]));
    }
    if (tid < 64) ((float*)(P.ws + OFF_DEC))[(size_t)(chain * 132 + cp) * 64 + tid] = __expf(cum[tl * 64 + tid]);
    __syncthreads();
    f32x4 acc[2][4];
#pragma unroll
    for (int m = 0; m < 2; ++m)
#pragma unroll
        for (int n = 0; n < 4; ++n) acc[m][n] = (f32x4){0.f, 0.f, 0.f, 0.f};
    wave_mma<2, 4>(VTs + (w * 32) * GS, GS, KTs, GS, 64, acc);
    bf16* ST = (bf16*)(P.ws + OFF_Y) + (size_t)(chain * 132 + cp) * 8192;
#pragma unroll
    for (int m = 0; m < 2; ++m)
#pragma unroll
        for (int n = 0; n < 4; ++n)
#pragma unroll
            for (int jj = 0; jj < 4; ++jj) ST[(w * 32 + m * 16 + fq * 4 + jj) * 64 + n * 16 + fr] = (bf16)f2bf(acc[m][n][jj]);
}
DEVI void gla_scan_phase(const Params& P) {
    bf16* ST = (bf16*)(P.ws + OFF_Y);
    const float* DEC = (const float*)(P.ws + OFF_DEC);
    for (int g = lbid() * NTHREADS + ltid(); g < 16 * 2048; g += gridDim.x * NTHREADS) {
        const int chain = g >> 11, idx = (g & 2047) * 4, d = idx & 63;
        bf16* p = ST + (size_t)chain * 132 * 8192 + idx;
        const float* dc = DEC + (size_t)chain * 132 * 64 + d;
        float S0 = 0.f, S1 = 0.f, S2 = 0.f, S3 = 0.f;
        for (int c0 = 0; c0 < 132; c0 += 12) {
            v2u Lv[12]; f32x4 dv[12];
#pragma unroll
            for (int u = 0; u < 12; ++u) { Lv[u] = *(const v2u*)(p + (size_t)(c0 + u) * 8192); dv[u] = *(const f32x4*)(dc + (c0 + u) * 64); }
#pragma unroll
            for (int u = 0; u < 12; ++u) {
                v2u o; o.x = pk2(S0, S1); o.y = pk2(S2, S3);
                *(v2u*)(p + (size_t)(c0 + u) * 8192) = o;
                S0 = dv[u].x * S0 + bflo(Lv[u].x); S1 = dv[u].y * S1 + bfhi(Lv[u].x);
                S2 = dv[u].z * S2 + bflo(Lv[u].y); S3 = dv[u].w * S3 + bfhi(Lv[u].y);
            }
        }
    }
}
DEVI void gla_out_item(const Params& P, int l, int it, bool skip_ctx, unsigned char* smem) {
    const int tid = ltid(), lane = tid & 63, w = tid >> 6, fr = lane & 15, fq = lane >> 4;
    const int bh = it / 132, ci = it - bh * 132;
    if (skip_ctx && ci < 4) return;
    const int b = bh >> 2, h = bh & 3;
    const int row0 = ci < 4 ? ML + b * CTXL + ci * 64 : b * SEQ + (ci - 4) * 64;
    const bf16* Z = (const bf16*)(P.ws + OFF_BIG);
    float* cum = (float*)smem;
    bf16* Pw = (bf16*)smem + w * 16 * GS;
    bf16* QA = (bf16*)(smem + 16384);
    bf16* KB = QA + 64 * GS;
    bf16* VTs = KB + 64 * GS;
    float* abuf = (float*)(smem + 16384 + 256 * GS * 2);
    f32x4 O[1][8];
#pragma unroll
    for (int n = 0; n < 8; ++n) O[0][n] = (f32x4){0.f, 0.f, 0.f, 0.f};
    __syncthreads();
    gla_load_vt(P, b, h, ci < 4 ? SEQ + ci * 64 : (ci - 4) * 64, VTs);
    for (int dir = 0; dir < 2; ++dir) {
        const int chain = (b * 4 + h) * 2 + dir;
        const int cp = dir ? (ci < 4 ? 3 - ci : 135 - ci) : ci;
        gla_cumsum(P, l, Z, row0, h, dir, cum, abuf);
#pragma unroll
        for (int i = 0; i < 2; ++i) {
            int c = tid + NTHREADS * i;
            int s = c >> 3, d0 = (c & 7) * 8;
            v4u uq = *(const v4u*)(Z + (size_t)(row0 + s) * NZ + h * 64 + d0);
            v4u uk = *(const v4u*)(Z + (size_t)(row0 + s) * NZ + 256 + h * 64 + d0);
            float qv[8] = {bflo(uq.x), bfhi(uq.x), bflo(uq.y), bfhi(uq.y), bflo(uq.z), bfhi(uq.z), bflo(uq.w), bfhi(uq.w)};
            float kv[8] = {bflo(uk.x), bfhi(uk.x), bflo(uk.y), bfhi(uk.y), bflo(uk.z), bfhi(uk.z), bflo(uk.w), bfhi(uk.w)};
            unsigned qo[4], ko[4];
#pragma unroll
            for (int q = 0; q < 4; ++q) {
                float c0 = cum[s * 64 + d0 + 2 * q], c1 = cum[s * 64 + d0 + 2 * q + 1];
                qo[q] = pk2(qv[2 * q] * 0.125f * __expf(c0), qv[2 * q + 1] * 0.125f * __expf(c1));
                ko[q] = pk2(kv[2 * q] * __expf(-c0), kv[2 * q + 1] * __expf(-c1));
            }
            *(v4u*)(QA + s * GS + d0) = (v4u){qo[0], qo[1], qo[2], qo[3]};
            *(v4u*)(KB + s * GS + d0) = (v4u){ko[0], ko[1], ko[2], ko[3]};
        }
        __syncthreads();
        f32x4 S[1][4];
#pragma unroll
        for (int n = 0; n < 4; ++n) S[0][n] = (f32x4){0.f, 0.f, 0.f, 0.f};
        wave_mma<1, 4>(QA + (w * 16) * GS, GS, KB, GS, 64, S);
#pragma unroll
        for (int n = 0; n < 4; ++n)
#pragma unroll
            for (int jj = 0; jj < 4; ++jj) {
                int t = w * 16 + fq * 4 + jj, s = n * 16 + fr;
                bool keep = dir ? (s >= t) : (s <= t);
                Pw[(fq * 4 + jj) * GS + s] = (bf16)f2bf(keep ? S[0][n][jj] : 0.f);
            }
        LDS_WAIT();
        __builtin_amdgcn_wave_barrier();
        wave_mma<1, 8>(Pw, GS, VTs, GS, 64, O);
        {
            const bf16* Sin = (const bf16*)(P.ws + OFF_Y) + (size_t)(chain * 132 + cp) * 8192;
#pragma unroll
            for (int ks = 0; ks < 2; ++ks) {
                bf16x8 a = *(const bf16x8*)(QA + (w * 16 + fr) * GS + ks * 32 + fq * 8);
#pragma unroll
                for (int n = 0; n < 8; ++n) {
                    bf16x8 bb = *(const bf16x8*)(Sin + (n * 16 + fr) * 64 + ks * 32 + fq * 8);
                    O[0][n] = __builtin_amdgcn_mfma_f32_16x16x32_bf16(a, bb, O[0][n], 0, 0, 0);
                }
            }
        }
        __syncthreads();
    }
    float ss[4];
#pragma unroll
    for (int jj = 0; jj < 4; ++jj) {
        float s = 0.f;
#pragma unroll
        for (int n = 0; n < 8; ++n) s += O[0][n][jj] * O[0][n][jj];
        s += __shfl_xor(s, 1); s += __shfl_xor(s, 2); s += __shfl_xor(s, 4); s += __shfl_xor(s, 8);
        ss[jj] = rsqrtf(s * (1.f / 128.f) + EPS);
    }
    bf16* YA = (bf16*)(P.ws + OFF_YA);
    const float* gn = P.gla_norm + l * 128;
#pragma unroll
    for (int n = 0; n < 8; ++n) {
        const int e = n * 16 + fr;
        const float gnv = gn[e];
#pragma unroll
        for (int jj = 0; jj < 4; ++jj) {
            int row = row0 + w * 16 + fq * 4 + jj;
            float gv = bf2f(Z[(size_t)row * NZ + 1024 + h * 128 + e]);
            YA[boff(row, h * 128 + e, 512)] = (bf16)f2bf(O[0][n][jj] * ss[jj] * gnv * siluf_(gv));
        }
    }
}

constexpr int KS_STRIDE = 104, VS_STRIDE = 72;
constexpr int ATT_BUF = 64 * KS_STRIDE * 2 + 64 * VS_STRIDE * 2;
DEVI void attn_item(const Params& P, int b, int h, int q0  , int k_lo, int k_hi, unsigned char* smem) {
    const int tid = ltid(), lane = tid & 63, w = tid >> 6, fr = lane & 15, fq = lane >> 4;
    const bf16* Q = (const bf16*)(P.ws + OFF_Q) + (size_t)(b * 8 + h) * NPOS * 96;
    const bf16* KF = (const bf16*)(P.ws + OFF_K) + (size_t)(b * 8 + h) * NPOS * 96;
    const bf16* VT = (const bf16*)(P.ws + OFF_VT) + (size_t)(b * 8 + h) * 64 * NPOS;
    bf16x8 Qf[2][3];
#pragma unroll
    for (int mi = 0; mi < 2; ++mi)
#pragma unroll
        for (int ks = 0; ks < 3; ++ks) Qf[mi][ks] = *(const bf16x8*)(Q + (size_t)(q0 + w * 32 + mi * 16 + fr) * 96 + ks * 32 + fq * 8);
    f32x4 O[2][4];
    float mrun[2], lrun[2];
#pragma unroll
    for (int mi = 0; mi < 2; ++mi) {
#pragma unroll
        for (int n = 0; n < 4; ++n) O[mi][n] = (f32x4){0.f, 0.f, 0.f, 0.f};
        mrun[mi] = 0.f; lrun[mi] = 0.f;
    }
    int kg[3], kl[3], vg[2], vl[2];
#pragma unroll
    for (int i = 0; i < 3; ++i) { int c = tid + NTHREADS * i; int key = c / 12, part = c - key * 12; kg[i] = key * 96 + part * 8; kl[i] = key * KS_STRIDE + part * 8; }
#pragma unroll
    for (int i = 0; i < 2; ++i) { int c = tid + NTHREADS * i; int dv = c >> 3, part = c & 7; vg[i] = dv * NPOS + part * 8; vl[i] = 64 * KS_STRIDE + dv * VS_STRIDE + part * 8; }
    v4u kr[3], vr[2];
#pragma unroll
    for (int i = 0; i < 3; ++i) kr[i] = *(const v4u*)(KF + (size_t)k_lo * 96 + kg[i]);
#pragma unroll
    for (int i = 0; i < 2; ++i) vr[i] = *(const v4u*)(VT + k_lo + vg[i]);
    __syncthreads();
    {
        bf16* B0 = (bf16*)smem;
#pragma unroll
        for (int i = 0; i < 3; ++i) *(v4u*)(B0 + kl[i]) = kr[i];
#pragma unroll
        for (int i = 0; i < 2; ++i) *(v4u*)(B0 + vl[i]) = vr[i];
    }
    __syncthreads();
    int cur = 0;
    for (int k0 = k_lo; k0 < k_hi; k0 += 64) {
        const bool more = (k0 + 64 < k_hi);
        const bf16* Ks = (const bf16*)(smem + cur * ATT_BUF);
        const bf16* Vs = Ks + 64 * KS_STRIDE;
        f32x4 S[2][4];
#pragma unroll
        for (int mi = 0; mi < 2; ++mi)
#pragma unroll
            for (int n = 0; n < 4; ++n) { const float nm = -mrun[mi]; S[mi][n] = (f32x4){nm, nm, nm, nm}; }
#pragma unroll
        for (int ks = 0; ks < 3; ++ks) {
            bf16x8 kf[4];
#pragma unroll
            for (int n = 0; n < 4; ++n) kf[n] = *(const bf16x8*)(Ks + (n * 16 + fr) * KS_STRIDE + ks * 32 + fq * 8);
#pragma unroll
            for (int mi = 0; mi < 2; ++mi)
#pragma unroll
                for (int n = 0; n < 4; ++n) S[mi][n] = __builtin_amdgcn_mfma_f32_16x16x32_bf16(kf[n], Qf[mi][ks], S[mi][n], 0, 0, 0);
        }
        bf16x8 vf0[4], vf1[4];
#pragma unroll
        for (int n = 0; n < 4; ++n) {
            v2u lo = *(const v2u*)(Vs + (n * 16 + fr) * VS_STRIDE + fq * 4);
            v2u hi = *(const v2u*)(Vs + (n * 16 + fr) * VS_STRIDE + 16 + fq * 4);
            v4u vv = (v4u){lo.x, lo.y, hi.x, hi.y};
            vf0[n] = __builtin_bit_cast(bf16x8, vv);
        }
        if (more) {
#pragma unroll
            for (int i = 0; i < 3; ++i) kr[i] = *(const v4u*)(KF + (size_t)(k0 + 64) * 96 + kg[i]);
#pragma unroll
            for (int i = 0; i < 2; ++i) vr[i] = *(const v4u*)(VT + (k0 + 64) + vg[i]);
        }
        const bool first = (k0 == k_lo);
        float mx[2];
#pragma unroll
        for (int mi = 0; mi < 2; ++mi) {
            float m0 = fmaxf(fmaxf(S[mi][0][0], S[mi][0][1]), fmaxf(S[mi][0][2], S[mi][0][3]));
#pragma unroll
            for (int n = 1; n < 4; ++n) m0 = fmaxf(m0, fmaxf(fmaxf(S[mi][n][0], S[mi][n][1]), fmaxf(S[mi][n][2], S[mi][n][3])));
            m0 = fmaxf(m0, __shfl_xor(m0, 16));
            m0 = fmaxf(m0, __shfl_xor(m0, 32));
            mx[mi] = m0;
        }
        if (__any(first || mx[0] > 8.f || mx[1] > 8.f)) {
#pragma unroll
            for (int mi = 0; mi < 2; ++mi) {
                const bool upd = first || mx[mi] > 8.f;
                const float dm = upd ? mx[mi] : 0.f;
                const float alpha = first ? 0.f : __builtin_amdgcn_exp2f(-dm);
                mrun[mi] += dm;
                lrun[mi] *= alpha;
#pragma unroll
                for (int n = 0; n < 4; ++n) {
                    O[mi][n][0] *= alpha; O[mi][n][1] *= alpha; O[mi][n][2] *= alpha; O[mi][n][3] *= alpha;
                    S[mi][n][0] -= dm; S[mi][n][1] -= dm; S[mi][n][2] -= dm; S[mi][n][3] -= dm;
                }
            }
        }
        float psum[2] = {0.f, 0.f};
#pragma unroll
        for (int s2 = 0; s2 < 2; ++s2) {
            bf16x8 Pb[2];
#pragma unroll
            for (int mi = 0; mi < 2; ++mi) {
#pragma unroll
                for (int n = 2 * s2; n < 2 * s2 + 2; ++n)
#pragma unroll
                    for (int jj = 0; jj < 4; ++jj) { float p = __builtin_amdgcn_exp2f(S[mi][n][jj]); S[mi][n][jj] = p; psum[mi] += p; }
                const v4u pk = pack8_for_mfma(S[mi][2 * s2][0], S[mi][2 * s2][1], S[mi][2 * s2][2], S[mi][2 * s2][3],
                                              S[mi][2 * s2 + 1][0], S[mi][2 * s2 + 1][1], S[mi][2 * s2 + 1][2], S[mi][2 * s2 + 1][3]);
                Pb[mi] = __builtin_bit_cast(bf16x8, pk);
            }
            if (s2 == 0) {
#pragma unroll
                for (int n = 0; n < 4; ++n) {
                    v2u lo = *(const v2u*)(Vs + (n * 16 + fr) * VS_STRIDE + 32 + fq * 4);
                    v2u hi = *(const v2u*)(Vs + (n * 16 + fr) * VS_STRIDE + 48 + fq * 4);
                    v4u vv = (v4u){lo.x, lo.y, hi.x, hi.y};
                    vf1[n] = __builtin_bit_cast(bf16x8, vv);
                }
            }
#pragma unroll
            for (int n = 0; n < 4; ++n) {
                const bf16x8 vf = (s2 == 0) ? vf0[n] : vf1[n];
#pragma unroll
                for (int mi = 0; mi < 2; ++mi) O[mi][n] = __builtin_amdgcn_mfma_f32_16x16x32_bf16(vf, Pb[mi], O[mi][n], 0, 0, 0);
            }
        }
        lrun[0] += psum[0]; lrun[1] += psum[1];
        if (more) {
            bf16* Bn = (bf16*)(smem + (cur ^ 1) * ATT_BUF);
#pragma unroll
            for (int i = 0; i < 3; ++i) *(v4u*)(Bn + kl[i]) = kr[i];
#pragma unroll
            for (int i = 0; i < 2; ++i) *(v4u*)(Bn + vl[i]) = vr[i];
        }
        __syncthreads();
        cur ^= 1;
    }
    bf16* YC = (bf16*)(P.ws + OFF_YC);
#pragma unroll
    for (int mi = 0; mi < 2; ++mi) {
        float l = lrun[mi];
        l += __shfl_xor(l, 16); l += __shfl_xor(l, 32);
        const float inv = 1.f / l;
        const int pos = q0 + w * 32 + mi * 16 + fr;
        const int row = row_of_pos(b, pos);
#pragma unroll
        for (int n = 0; n < 4; ++n) {
            v2u o; o.x = pk2(O[mi][n][0] * inv, O[mi][n][1] * inv); o.y = pk2(O[mi][n][2] * inv, O[mi][n][3] * inv);
            *(v2u*)(YC + boff(row, h * 64 + n * 16 + fq * 4, 512)) = o;
        }
    }
}

template <int MB>
DEVI void merge_tile(const Params& P, int row0, int col0, unsigned char* smem) {
    EPI_COORDS
    const bf16* H = (const bf16*)(P.ws + OFF_H);
    const bf16* WG = (const bf16*)(P.ws + OFF_WGATE);
    const bf16* WB = (const bf16*)(P.ws + OFF_WBR);
    bf16* M1 = (bf16*)(P.ws + OFF_BIG);
    f32x4 tot[MB][4]; zero_acc<MB>(tot);
    for (int i = 0; i < 3; ++i) {
        f32x4 acc[MB][4]; zero_acc<MB>(acc);
        gemm_ml<MB, 3>(H, D, WG + (size_t)i * D * D, D, D, row0, col0, smem, acc);
        unsigned gpr[2][4][2];
        unsigned* gpl = (unsigned*)(smem + 49152) + tid;
#pragma unroll
        for (int m = 0; m < MB; ++m)
#pragma unroll
            for (int n = 0; n < 4; ++n) {
                const unsigned g0 = pk2(sigmoidf_(acc[m][n][0]), sigmoidf_(acc[m][n][1]));
                const unsigned g1 = pk2(sigmoidf_(acc[m][n][2]), sigmoidf_(acc[m][n][3]));
                if (m < 2) { gpr[m][n][0] = g0; gpr[m][n][1] = g1; }
                else { gpl[((m - 2) * 8 + n * 2 + 0) * NTHREADS] = g0; gpl[((m - 2) * 8 + n * 2 + 1) * NTHREADS] = g1; }
            }
        zero_acc<MB>(acc);
        const bf16* Yi = (const bf16*)(P.ws + (i == 0 ? OFF_YA : i == 1 ? OFF_YB : OFF_YC));
        gemm_ml<MB, 3>(Yi, 512, WB + (size_t)i * D * 512, 512, 512, row0, col0, smem, acc);
#pragma unroll
        for (int m = 0; m < MB; ++m)
#pragma unroll
            for (int n = 0; n < 4; ++n) {
                unsigned g0, g1;
                if (m < 2) { g0 = gpr[m][n][0]; g1 = gpr[m][n][1]; }
                else { g0 = gpl[((m - 2) * 8 + n * 2 + 0) * NTHREADS]; g1 = gpl[((m - 2) * 8 + n * 2 + 1) * NTHREADS]; }
                tot[m][n][0] += bflo(g0) * acc[m][n][0]; tot[m][n][1] += bfhi(g0) * acc[m][n][1];
                tot[m][n][2] += bflo(g1) * acc[m][n][2]; tot[m][n][3] += bfhi(g1) * acc[m][n][3];
            }
    }
#pragma unroll
    for (int m = 0; m < MB; ++m)
#pragma unroll
        for (int n = 0; n < 4; ++n)
#pragma unroll
            for (int jj = 0; jj < 4; ++jj) {
                int row = row0 + wr * (MB * 16) + m * 16 + fq * 4 + jj;
                int col = col0 + wc * 64 + n * 16 + fr;
                M1[boff(row, col, D)] = (bf16)f2bf(tot[m][n][jj]);
            }
}
DEVI void merge_phase(const Params& P, bool with_ctx, unsigned char* smem) {
    const int nbig = (ML / 128) * 8, total = nbig + (with_ctx ? (MC / 64) * 8 : 0);
    FOR_ITEMS(L, total) {
        if (L < nbig) { int tm, tn; tile_map(L, ML / 128, 8, tm, tn); merge_tile<4>(P, tm * 128, tn * 128, smem); }
        else { int r = L - nbig; merge_tile<2>(P, ML + (r >> 3) * 64, (r & 7) * 128, smem); }
    }
}

#define XB_TMO      128
#define XB_XCNT(j)  (256  + 64 * (j))
#define XB_XSUB(j)  (1280 + 64 * (j))
#define XB_XGEN(j)  (2304 + 64 * (j))
#define XB_TOP      3328
#define XB_TOPGEN   3392
#define XCD_BAR_WORDS 3456
#define XB_SPIN_CAP (1u << 18)
DEVI unsigned xb_ld(unsigned* p)              { return __hip_atomic_load(p, __ATOMIC_RELAXED, __HIP_MEMORY_SCOPE_AGENT); }
DEVI unsigned xb_add(unsigned* p, unsigned v) { return __hip_atomic_fetch_add(p, v, __ATOMIC_RELAXED, __HIP_MEMORY_SCOPE_AGENT); }
DEVI unsigned xb_xcc_id() { return (unsigned)__builtin_amdgcn_s_getreg((3 << 11) | 20) & 0xFu; }
#define XB_SPIN(cond, bar) do { unsigned _sp = 0; while (cond) { __builtin_amdgcn_s_sleep(1); \
    if ((++_sp & 255u) == 0u) { if (xb_ld(&(bar)[XB_TMO])) break; if (_sp > XB_SPIN_CAP) { atomicAdd(&(bar)[XB_TMO], 1u); break; } } } } while (0)
struct XcdBarrier { unsigned* bar; unsigned x; volatile LAS unsigned* st; };
DEVI XcdBarrier xcd_barrier_post(unsigned* bar, volatile LAS unsigned* st) {
    XcdBarrier b; b.bar = bar; b.x = xb_xcc_id(); b.st = st;
    if (threadIdx.x == 0) (void)xb_add(&bar[XB_XCNT(b.x)], 1u);
    return b;
}
DEVI void xcd_barrier_complete(unsigned* bar, unsigned x, unsigned& nloc, unsigned& nx) {
    const unsigned G = gridDim.x * gridDim.y * gridDim.z;
    unsigned sum, cnt, mine, sp = 0u;
    for (;;) {
        sum = 0u; cnt = 0u; mine = 0u;
#pragma unroll
        for (unsigned j = 0; j < 16; ++j) { const unsigned c = xb_ld(&bar[XB_XCNT(j)]); sum += c; cnt += (c > 0u) ? 1u : 0u; mine = (j == x) ? c : mine; }
        if (sum == G) break;
        __builtin_amdgcn_s_sleep(1);
        if ((++sp & 255u) == 0u) { if (xb_ld(&bar[XB_TMO])) break; if (sp > XB_SPIN_CAP) { atomicAdd(&bar[XB_TMO], 1u); break; } }
    }
    nloc = mine > 0u ? mine : 1u; nx = cnt > 0u ? cnt : 1u;
}
DEVI void xcd_barrier(const XcdBarrier& b) {
    asm volatile("s_waitcnt vmcnt(0)" ::: "memory");
    __syncthreads();
    if (threadIdx.x == 0) {
        unsigned* bar = b.bar;
        __builtin_amdgcn_s_waitcnt(0);
        unsigned nloc = b.st[0], nx = b.st[1];
        if (nloc == 0u) { xcd_barrier_complete(bar, b.x, nloc, nx); b.st[0] = nloc; b.st[1] = nx; }
        const unsigned old = xb_add(&bar[XB_XSUB(b.x)], 1u);
        const unsigned gen = old / nloc;
        if (old + 1u == (gen + 1u) * nloc) {
            __builtin_amdgcn_fence(__ATOMIC_RELEASE, "agent");
            asm volatile("s_waitcnt vmcnt(0)" ::: "memory");
            const unsigned og = xb_add(&bar[XB_TOP], 1u);
            const unsigned tg = og / nx;
            if (og + 1u == (tg + 1u) * nx) xb_add(&bar[XB_TOPGEN], 1u);
            else XB_SPIN(xb_ld(&bar[XB_TOPGEN]) == tg, bar);
            __builtin_amdgcn_fence(__ATOMIC_ACQUIRE, "agent");
            xb_add(&bar[XB_XGEN(b.x)], 1u);
            asm volatile("s_waitcnt vmcnt(0)" ::: "memory");
        } else {
            XB_SPIN(xb_ld(&bar[XB_XGEN(b.x)]) == gen, bar);
            __builtin_amdgcn_fence(__ATOMIC_ACQUIRE, "agent");
            asm volatile("s_waitcnt vmcnt(0)" ::: "memory");
        }
    }
    __syncthreads();
}

__global__ void __launch_bounds__(NTHREADS, 2) mega(Params P0) {
    extern __shared__ __attribute__((aligned(16))) unsigned char smem[];
    volatile LAS unsigned* bst = (volatile LAS unsigned*)(smem + LDS_MAIN);
    if (threadIdx.x < 2) bst[threadIdx.x] = 0u;
    __syncthreads();
    XcdBarrier xbar; xbar.bar = (unsigned*)(P0.ws + OFF_BAR); xbar.x = 0; xbar.st = bst;
    if (P0.coop == 1) xbar = xcd_barrier_post((unsigned*)(P0.ws + OFF_BAR), bst);
    for (int ph = P0.ph_lo; ph < P0.ph_hi; ++ph) {
        Params P = P0;
        {
            size_t z = 0;
            asm volatile("" : "+s"(z));
            const float** pp = (const float**)&P;
#pragma unroll
            for (int i = 0; i < 21; ++i) pp[i] = pp[i] + z;
            P.out = P.out + z; P.ws = P.ws + z;
        }
        unsigned char* ws = P.ws;
        const float* MOD = (const float*)(ws + OFF_MOD);
#if DUP_MASK
        const int nrep = (ph >= 2 && ((DUP_MASK >> ((ph - 2) % 15)) & 1)) ? 2 : 1;
        for (int rep = 0; rep < nrep; ++rep) {
        if (rep) xcd_barrier(xbar);
#endif
        if (ph == 0) {
            prep_phase(P, 0, true, smem);
        } else if (ph == 1) {
            norm_phase(P, MT, true, false, 0.f, nullptr, nullptr, 0, true, P.norm_pre + 0 * D, MOD, 0);
        } else {
            const int l = (ph - 2) / 15, s = (ph - 2) % 15;
            const bool last = (l == 1);
            const float* modl = MOD + (size_t)l * 3 * NMOD;
            const int mrows = last ? ML : MT;
            switch (s) {
            case 0: gemm_gu_phase(P, 0, MT / 256, smem); break;
            case 1: gemm_plain_phase((const bf16*)(ws + OFF_BIG), DFF, (const bf16*)(ws + OFF_WD), DFF, (bf16*)(ws + OFF_Y), D, ML, MC, smem); break;
            case 2: norm_phase(P, MT, l == 0, true, 0.5f, P.norm_post + (l * 3 + 0) * D, modl, 2, true, P.norm_pre + (l * 3 + 1) * D, modl, 3); break;
            case 3: gemm_win_phase(P, smem); break;
            case 4: {
                const int n_fft = last ? 1024 : 2048, n_q = 132 * 6, n_kv = 132 * 8;
                const int total = n_fft + n_q + n_kv;
                const float* TW = (const float*)(ws + OFF_TW);
                const bf16* PT = (const bf16*)(ws + OFF_Y);
                FOR_ITEMS(it, total) {
                    int r = it;
                    if (r < n_fft) {
                        const int isc = r >> 10, cc = r & 1023, b = cc >> 9, c = cc & 511;
                        const bf16* re = PT + ((size_t)(b * 1024 + c)) * NPOS + (isc ? SEQ : 0);
                        const bf16* im = re + (size_t)512 * NPOS;
                        if (!isc) fft_item(re, im, SEQ, (bf16*)re, 1, 9.765625e-4f  , TW, smem);
                        else fft_item(re, im, CTXL, (bf16*)re, 1, 5.524271728019903e-3f  , TW, smem);
                        continue;
                    }
                    r -= n_fft;
                    if (r < n_q) { mla_q_tile(P, r / 6, r % 6, smem); continue; }
                    r -= n_q;
                    mla_kv_tile(P, r >> 3, r & 7, smem);
                }
            } break;
            case 5: {
                const int n_tr = last ? 2048 : 2112, n_al = 2 * 8 * 64, n_ac = last ? 0 : 2 * 8 * 2;
                const int total = n_tr + n_al + n_ac;
                FOR_ITEMS(it, total) {
                    int r = it;
                    if (r < n_tr) { ybt_transpose_item(P, r, smem); continue; }
                    r -= n_tr;
                    if (r < n_al) { attn_item(P, r >> 9, (r >> 6) & 7, (r & 63) * 128, 0, NPOS, smem); continue; }
                    r -= n_al;
                    attn_item(P, r >> 4, (r >> 1) & 7, SEQ + (r & 1) * 128, SEQ, NPOS, smem);
                }
            } break;
            case 6:
                FOR_ITEMS(it, 16 * 132) gla_local_item(P, l, it, smem);
                break;
            case 7: gla_scan_phase(P); break;
            case 8:
                FOR_ITEMS(it, 8 * 132) gla_out_item(P, l, it, last, smem);
                break;
            case 9: merge_phase(P, !last, smem); break;
            case 10: gemm_plain_phase((const bf16*)(ws + OFF_BIG), D, (const bf16*)(ws + OFF_WOUT), D, (bf16*)(ws + OFF_Y), D, ML, last ? 0 : MC, smem); break;
            case 11: norm_phase(P, mrows, false, true, 1.0f, P.norm_post + (l * 3 + 1) * D, modl, 5, true, P.norm_pre + (l * 3 + 2) * D, modl, 6); break;
            case 12: gemm_gu_phase(P, 1, mrows / 256, smem); break;
            case 13: gemm_plain_phase((const bf16*)(ws + OFF_BIG), DFF, (const bf16*)(ws + OFF_WD) + (size_t)D * DFF, DFF, (bf16*)(ws + OFF_Y), D, ML, last ? 0 : MC, smem); break;
            case 14:
                norm_phase(P, mrows, false, true, 0.5f, P.norm_post + (l * 3 + 2) * D, modl, 8, !last, P.norm_pre + ((l + 1) * 3 + 0) * D, MOD + (size_t)(l + 1) * 3 * NMOD, 0);
                if (!last) prep_phase(P, 1, false, smem);
                break;
            }
        }
#if DUP_MASK
        }
#endif
        if (ph + 1 < P0.ph_hi) { if (P0.coop == 1) xcd_barrier(xbar); else if (P0.coop == 2) cg::this_grid().sync(); }
    }
}

extern "C" void kernel_launch(void* const* d_in, const int* in_sizes, int n_in, void* d_out, int out_size, void* d_ws, size_t ws_size, hipStream_t stream) {
    static int grid = 0;
    if (grid == 0) {
        if (n_in != 21 || out_size != ML * D || ws_size < WS_END) { fprintf(stderr, "kernel_launch: unexpected shapes/workspace (n_in %d out %d ws %zu need %zu)\n", n_in, out_size, ws_size, (size_t)WS_END); grid = -1; return; }
        int dev = 0, cus = 0, per_cu = 0;
        hipGetDevice(&dev);
        hipDeviceGetAttribute(&cus, hipDeviceAttributeMultiprocessorCount, dev);
        hipFuncSetAttribute((const void*)mega, hipFuncAttributeMaxDynamicSharedMemorySize, LDS_BYTES);
        hipOccupancyMaxActiveBlocksPerMultiprocessor(&per_cu, (const void*)mega, NTHREADS, LDS_BYTES);
        if (per_cu < 1) per_cu = 1;
        if (per_cu > 2) per_cu = 2;
        grid = cus * per_cu;
        (void)hipGetLastError();
    }
    if (grid < 0) return;
    Params p{};
    const float** pp = (const float**)&p;
    for (int i = 0; i < 21; ++i) pp[i] = (const float*)d_in[i];
    p.out = (float*)d_out; p.ws = (unsigned char*)d_ws;
#if MK_PER_PHASE
    for (int ph = 0; ph < NPHASES; ++ph) {
        p.ph_lo = ph; p.ph_hi = ph + 1; p.coop = 0;
        hipLaunchKernelGGL(mega, dim3(grid), dim3(NTHREADS), LDS_BYTES, stream, p);
    }
#else
    p.ph_lo = 0; p.ph_hi = NPHASES; p.coop = 1;
    (void)hipMemsetAsync(d_ws, 0, BAR_BYTES, stream);
    void* args[] = {&p};
    hipError_t e = hipLaunchCooperativeKernel((const void*)mega, dim3(grid), dim3(NTHREADS), args, LDS_BYTES, stream);
    if (e != hipSuccess) fprintf(stderr, "cooperative launch failed: %s (grid %d)\n", hipGetErrorString(e), grid);
#endif
}
```

```cpp
#include <hip/hip_runtime.h>
#include <hip/hip_cooperative_groups.h>
#include <stdint.h>
#include <cstdio>
namespace cg = cooperative_groups;

#ifndef DUP_MASK
#define DUP_MASK 0
#endif
#ifndef MK_PER_PHASE
#define MK_PER_PHASE 0
#endif

typedef unsigned short bf16;
typedef short bf16x8 __attribute__((ext_vector_type(8)));
typedef float f32x4 __attribute__((ext_vector_type(4)));
typedef unsigned v4u __attribute__((ext_vector_type(4)));
typedef unsigned v2u __attribute__((ext_vector_type(2)));
#define DEVI __device__ __forceinline__
#define GAS __attribute__((address_space(1)))
#define LAS __attribute__((address_space(3)))

constexpr int D = 1024, NB = 2, SEQ = 8192, CTXL = 256, ML = NB * SEQ, MC = NB * CTXL, MT = ML + MC;
constexpr int DFF = 2816, NGU = 2 * DFF, DIN = 5824, NZ = 2304, NWIN = 3328, NPOS = SEQ + CTXL;
constexpr int NMOD = 9 * D;
constexpr float EPS = 1e-6f;
constexpr int NTHREADS = 256;
constexpr int LDS_MAIN = 73728;
constexpr int LDS_BYTES = LDS_MAIN + 64;
constexpr int NPHASES = 32;

constexpr size_t al(size_t x) { return (x + 255) & ~(size_t)255; }
constexpr size_t OFF_BAR = 0;
constexpr size_t BAR_BYTES = 16384;
constexpr size_t OFF_MOD = BAR_BYTES;
constexpr size_t OFF_ROPE = al(OFF_MOD + (size_t)2 * 3 * NMOD * 4);
constexpr size_t OFF_TW = al(OFF_ROPE + 128 * 8 * 2 * 4);
constexpr size_t OFF_DEC = al(OFF_TW + 4096 * 2 * 4);
constexpr size_t OFF_XC = al(OFF_DEC + 16 * 132 * 64 * 4);
constexpr size_t OFF_WGU = al(OFF_XC + (size_t)MC * D * 4);
constexpr size_t OFF_WD = al(OFF_WGU + (size_t)2 * NGU * D * 2);
constexpr size_t OFF_WIN = al(OFF_WD + (size_t)2 * D * DFF * 2);
constexpr size_t OFF_WGATE = al(OFF_WIN + (size_t)NWIN * D * 2);
constexpr size_t OFF_WBR = al(OFF_WGATE + (size_t)3072 * D * 2);
constexpr size_t OFF_WOUT = al(OFF_WBR + (size_t)3 * D * 512 * 2);
constexpr size_t OFF_WUQ = al(OFF_WOUT + (size_t)D * D * 2);
constexpr size_t OFF_WUKV = al(OFF_WUQ + (size_t)768 * 384 * 2);
constexpr size_t OFF_H = al(OFF_WUKV + (size_t)1024 * 256 * 2);
constexpr size_t OFF_BIG = al(OFF_H + (size_t)MT * D * 2);
constexpr size_t OFF_YC = OFF_BIG + (size_t)MT * NZ * 2;
constexpr size_t OFF_Y = al(OFF_BIG + (size_t)MT * DFF * 2);
constexpr size_t OFF_YA = al(OFF_Y + (size_t)MT * D * 2);
constexpr size_t OFF_YB = al(OFF_YA + (size_t)MT * 512 * 2);
constexpr size_t OFF_Q = al(OFF_YB + (size_t)MT * 512 * 2);
constexpr size_t OFF_K = al(OFF_Q + (size_t)16 * NPOS * 96 * 2);
constexpr size_t OFF_VT = al(OFF_K + (size_t)16 * NPOS * 96 * 2);
constexpr size_t OFF_GVT = al(OFF_VT + (size_t)16 * 64 * NPOS * 2);
constexpr size_t WS_END = al(OFF_GVT + (size_t)8 * 128 * NPOS * 2);
static_assert((size_t)MT * NZ * 2 + (size_t)MT * 512 * 2 == (size_t)MT * DFF * 2, "YC fits the ACT tail");
static_assert((size_t)2 * 1024 * NPOS * 2 == (size_t)MT * D * 2 && (size_t)16 * 132 * 8192 * 2 == (size_t)MT * D * 2, "PT/ST alias Y");

struct Params {
    const float *x, *c, *ctx, *c_ctx, *w_mod, *b_mod, *norm_pre, *norm_post, *wg, *wu, *wd, *w_in, *gla_wdec, *gla_bdec, *gla_norm,
        *q_norm, *w_uq, *kv_norm, *w_ukv, *w_branch, *w_out;
    float* out;
    unsigned char* ws;
    int ph_lo, ph_hi, coop, pad;
};

DEVI int ltid() { int t = threadIdx.x; asm volatile("" : "+v"(t)); return t; }
DEVI int lbid() { int t = blockIdx.x; asm volatile("" : "+s"(t)); return t; }
DEVI unsigned f2bf(float f) { unsigned u = __float_as_uint(f); return (u + 0x7fffu + ((u >> 16) & 1u)) >> 16; }
DEVI float bf2f(unsigned h) { return __uint_as_float(h << 16); }
DEVI unsigned pk2(float lo, float hi) { unsigned r; asm("v_cvt_pk_bf16_f32 %0, %1, %2" : "=v"(r) : "v"(lo), "v"(hi)); return r; }
DEVI float bflo(unsigned u) { return __uint_as_float(u << 16); }
DEVI float bfhi(unsigned u) { return __uint_as_float(u & 0xffff0000u); }
DEVI float sigmoidf_(float x) { return 1.f / (1.f + __expf(-x)); }
DEVI float siluf_(float x) { return x / (1.f + __expf(-x)); }
DEVI float logsigmoidf_(float x) { return fminf(x, 0.f) - __logf(1.f + __expf(-fabsf(x))); }
DEVI v4u pack8_for_mfma(float a0, float a1, float a2, float a3, float a4, float a5, float a6, float a7) {
    unsigned r0, r1, r2, r3;
    asm("v_cvt_pk_bf16_f32 %0, %4, %5\n\tv_cvt_pk_bf16_f32 %1, %6, %7\n\tv_cvt_pk_bf16_f32 %2, %8, %9\n\tv_cvt_pk_bf16_f32 %3, %10, %11\n\ts_nop 1"
        : "=&v"(r0), "=&v"(r1), "=&v"(r2), "=&v"(r3)
        : "v"(a0), "v"(a1), "v"(a2), "v"(a3), "v"(a4), "v"(a5), "v"(a6), "v"(a7));
    return (v4u){r0, r1, r2, r3};
}
#define LDS_WAIT() asm volatile("s_waitcnt lgkmcnt(0)" ::: "memory")
#define VM_WAIT() asm volatile("s_waitcnt vmcnt(0)" ::: "memory")

DEVI void dsincos(double x, double& s, double& c) {
    const double hp = 1.5707963267948966192313216916398;
    double kd = rint(x / hp);
    double r = x - kd * hp;
    int k = ((int)kd) & 3;
    double r2 = r * r;
    double sn = r * (1.0 + r2 * (-1.0 / 6 + r2 * (1.0 / 120 + r2 * (-1.0 / 5040 + r2 * (1.0 / 362880 + r2 * (-1.0 / 39916800 + r2 * (1.0 / 6227020800.0)))))));
    double cs = 1.0 + r2 * (-0.5 + r2 * (1.0 / 24 + r2 * (-1.0 / 720 + r2 * (1.0 / 40320 + r2 * (-1.0 / 3628800 + r2 * (1.0 / 479001600.0 + r2 * (-1.0 / 87178291200.0)))))));
    if (k == 0) { s = sn; c = cs; } else if (k == 1) { s = cs; c = -sn; } else if (k == 2) { s = -sn; c = -cs; } else { s = -cs; c = sn; }
}

DEVI size_t boff(int row, int k, int K) { return ((size_t)(row >> 4) * (K >> 5) + (k >> 5)) * 512 + (row & 15) * 32 + (k & 31); }
DEVI int row_of_pos(int b, int pos) { return pos < SEQ ? b * SEQ + pos : ML + b * CTXL + (pos - SEQ); }

template <int MB, int NS, bool SWAP = false, bool BLK = true>
DEVI void gemm_ml(const bf16* __restrict__ A, int lda, const bf16* __restrict__ Bt, int ldb, int K, int row0, int col0,
                  unsigned char* smem, f32x4 (&acc)[MB][4]) {
    const int tid = ltid(), lane = tid & 63, wid = tid >> 6, wr = wid >> 1, wc = wid & 1, fr = lane & 15, fq = lane >> 4;
    constexpr int AROWS = 32 * MB, ABYTES = AROWS * 64, STG = ABYTES + 8192, NA = AROWS / 64, NL = NA + 2;
    const int r_ = tid >> 2, c_ = (tid & 3) * 8;
    const bf16* ap = BLK ? A + (size_t)((row0 >> 4) + (r_ >> 4)) * (lda >> 5) * 512 + (r_ & 15) * 32 + c_ : A + (size_t)(row0 + r_) * lda + c_;
    const bf16* bp = BLK ? Bt + (size_t)((col0 >> 4) + (r_ >> 4)) * (ldb >> 5) * 512 + (r_ & 15) * 32 + c_ : Bt + (size_t)(col0 + r_) * ldb + c_;
    const size_t a64 = BLK ? (size_t)4 * (lda >> 5) * 512 : (size_t)64 * lda;
    const size_t b64 = BLK ? (size_t)4 * (ldb >> 5) * 512 : (size_t)64 * ldb;
#define GSTAGE(buf, kk) do { unsigned char* sa_ = smem + (buf) * STG; const size_t ko_ = BLK ? (size_t)(kk) * 16 : (size_t)(kk); \
    _Pragma("unroll") for (int i_ = 0; i_ < NA; ++i_) __builtin_amdgcn_global_load_lds((const GAS unsigned*)(ap + i_ * a64 + ko_), (LAS unsigned*)(sa_ + tid * 16 + i_ * 4096), 16, 0, 0); \
    _Pragma("unroll") for (int i_ = 0; i_ < 2; ++i_) __builtin_amdgcn_global_load_lds((const GAS unsigned*)(bp + i_ * b64 + ko_), (LAS unsigned*)(sa_ + ABYTES + tid * 16 + i_ * 4096), 16, 0, 0); } while (0)
    const int nk = K >> 5;
    __syncthreads();
#pragma unroll
    for (int s0 = 0; s0 < NS - 1; ++s0) if (s0 < nk) GSTAGE(s0, s0 * 32);
    int buf = 0;
    for (int it = 0; it < nk; ++it) {
        if (NS >= 3 && it + 1 < nk) asm volatile("s_waitcnt vmcnt(%0)" ::"n"(NL) : "memory");
        else asm volatile("s_waitcnt vmcnt(0)" ::: "memory");
        asm volatile("" ::: "memory");
        __builtin_amdgcn_s_barrier();
        asm volatile("" ::: "memory");
        if (it + NS - 1 < nk) { int nb = buf + NS - 1; if (nb >= NS) nb -= NS; GSTAGE(nb, (it + NS - 1) * 32); }
        const unsigned char* SA = smem + buf * STG;
        const unsigned char* SB = SA + ABYTES;
        bf16x8 Bf[4], Af[MB];
#pragma unroll
        for (int n = 0; n < 4; ++n) Bf[n] = *(const bf16x8*)(SB + (wc * 64 + n * 16 + fr) * 64 + fq * 16);
#pragma unroll
        for (int m = 0; m < MB; ++m) Af[m] = *(const bf16x8*)(SA + (wr * (MB * 16) + m * 16 + fr) * 64 + fq * 16);
        __builtin_amdgcn_sched_barrier(0);
#pragma unroll
        for (int m = 0; m < MB; ++m)
#pragma unroll
            for (int n = 0; n < 4; ++n) {
                if (SWAP) acc[m][n] = __builtin_amdgcn_mfma_f32_16x16x32_bf16(Bf[n], Af[m], acc[m][n], 0, 0, 0);
                else acc[m][n] = __builtin_amdgcn_mfma_f32_16x16x32_bf16(Af[m], Bf[n], acc[m][n], 0, 0, 0);
            }
        __builtin_amdgcn_sched_barrier(0);
        buf = (buf == NS - 1) ? 0 : buf + 1;
    }
#undef GSTAGE
}
template <int MB>
DEVI void zero_acc(f32x4 (&acc)[MB][4]) {
#pragma unroll
    for (int m = 0; m < MB; ++m)
#pragma unroll
        for (int n = 0; n < 4; ++n) acc[m][n] = (f32x4){0.f, 0.f, 0.f, 0.f};
}
DEVI int xcd_slot() { const int G = gridDim.x, b = lbid(); return (G & 7) ? b : (b & 7) * (G >> 3) + (b >> 3); }
#define FOR_ITEMS(L, total) for (int L##_r = 0, L##_s = xcd_slot(), L; L##_r < (total); L##_r += gridDim.x) if ((L = L##_r + L##_s) < (total))
DEVI void tile_map(int L, int MTILES, int NT, int& tm, int& tn) {
    const int PH = (MTILES % 8 == 0) ? 8 : (MTILES % 6 == 0) ? 6 : 4;
    int p = L / (PH * NT), w = L - p * PH * NT;
    tn = w / PH; tm = p * PH + (w - tn * PH);
}

DEVI void transpose_item(const float* __restrict__ W, int ldsrc, int k0, int n0, const float* __restrict__ kscale, bf16* __restrict__ WT, int ldk,
                         int R0, float* scr, int lane, bool blk = true) {
    {
        const int kq = lane >> 3, n4 = (lane & 7) * 4;
        f32x4 v[8];
#pragma unroll
        for (int i = 0; i < 8; ++i) v[i] = *(const f32x4*)(W + (size_t)(k0 + i * 8 + kq) * ldsrc + n0 + n4);
#pragma unroll
        for (int i = 0; i < 8; ++i) {
            const int kk = i * 8 + kq;
            const float sc = kscale ? kscale[k0 + kk] : 1.f;
            float* d = scr + kk * 33 + n4;
            d[0] = v[i].x * sc; d[1] = v[i].y * sc; d[2] = v[i].z * sc; d[3] = v[i].w * sc;
        }
    }
    LDS_WAIT();
    __builtin_amdgcn_wave_barrier();
    const int c = lane & 7;
#pragma unroll
    for (int j = 0; j < 4; ++j) {
        const int n = (lane >> 3) + 8 * j;
        const float* s = scr + (8 * c) * 33 + n;
        v4u o;
        o.x = pk2(s[0], s[33]); o.y = pk2(s[66], s[99]); o.z = pk2(s[132], s[165]); o.w = pk2(s[198], s[231]);
        *(v4u*)(WT + (blk ? boff(R0 + n, k0 + 8 * c, ldk) : (size_t)(R0 + n) * ldk + k0 + 8 * c)) = o;
    }
    LDS_WAIT();
    __builtin_amdgcn_wave_barrier();
}

DEVI void transpose_dispatch(const Params& P, int l, int it, float* scr, int lane) {
    unsigned char* ws = P.ws;
    int r = it;
    if (r < 4 * 1408) {
        int jh = r / 1408; r -= jh * 1408;
        int j = jh >> 1, half = jh & 1;
        int kb = r / 88, nb = r - kb * 88, n0 = nb * 32;
        const float* src = (half ? P.wu : P.wg) + (size_t)(l * 2 + j) * D * DFF;
        int R0 = (n0 >> 6) * 128 + ((n0 >> 5) & 1) * 64 + half * 32;
        transpose_item(src, DFF, kb * 64, n0, nullptr, (bf16*)(ws + OFF_WGU) + (size_t)j * NGU * D, D, R0, scr, lane);
        return;
    }
    r -= 4 * 1408;
    if (r < 2 * 1408) {
        int j = r / 1408; r -= j * 1408;
        int kb = r >> 5, nb = r & 31;
        transpose_item(P.wd + (size_t)(l * 2 + j) * DFF * D, D, kb * 64, nb * 32, nullptr, (bf16*)(ws + OFF_WD) + (size_t)j * D * DFF, DFF, nb * 32, scr, lane);
        return;
    }
    r -= 2 * 1408;
    if (r < 2912) {
        int kb = r / 182, nb = r - kb * 182, n0 = nb * 32;
        bf16* dst = (bf16*)(ws + OFF_WIN);
        int R0;
        if (n0 < 1536) R0 = n0;
        else if (n0 < 1568) R0 = 2176;
        else if (n0 < 2080) return;
        else if (n0 < 2464) R0 = 1536 + (n0 - 2080);
        else if (n0 < 2720) R0 = 1920 + (n0 - 2464);
        else if (n0 < 2752) R0 = 2208;
        else { dst = (bf16*)(ws + OFF_WGATE); R0 = n0 - 2752; }
        transpose_item(P.w_in + (size_t)l * D * DIN, DIN, kb * 64, n0, nullptr, dst, D, R0, scr, lane);
        return;
    }
    r -= 2912;
    if (r < 768) {
        int i = r >> 8; r &= 255;
        int kb = r >> 5, nb = r & 31;
        transpose_item(P.w_branch + (size_t)(l * 3 + i) * 512 * D, D, kb * 64, nb * 32, nullptr, (bf16*)(ws + OFF_WBR) + (size_t)i * D * 512, 512, nb * 32, scr, lane);
        return;
    }
    r -= 768;
    if (r < 512) {
        int kb = r >> 5, nb = r & 31;
        transpose_item(P.w_out + (size_t)l * D * D, D, kb * 64, nb * 32, nullptr, (bf16*)(ws + OFF_WOUT), D, nb * 32, scr, lane);
        return;
    }
    r -= 512;
    if (r < 144) {
        int kb = r / 24, nb = r - kb * 24;
        transpose_item(P.w_uq + (size_t)l * 384 * 768, 768, kb * 64, nb * 32, P.q_norm + l * 384, (bf16*)(ws + OFF_WUQ), 384, nb * 32, scr, lane, false);
        return;
    }
    r -= 144;
    {
        int kb = r >> 5, nb = r & 31;
        transpose_item(P.w_ukv + (size_t)l * 256 * 1024, 1024, kb * 64, nb * 32, P.kv_norm + l * 256, (bf16*)(ws + OFF_WUKV), 256, nb * 32, scr, lane, false);
    }
}
constexpr int N_TR_WAVE_ITEMS = 6 * 1408 + 2912 + 768 + 512 + 144 + 128;
constexpr int N_TR_BLOCK_ITEMS = N_TR_WAVE_ITEMS / 4;
static_assert(N_TR_WAVE_ITEMS % 4 == 0, "");

DEVI void fold_item(const Params& P, int l, int it, unsigned char* smem) {
    const int tid = ltid();
    const int g = it >> 4, k0 = (it & 15) * 64;
    float* Wt = (float*)smem;
    float* ct = Wt + 64 * 128;
    __syncthreads();
    const float* src = P.w_in + (size_t)l * D * DIN + 1568 + g * 128;
    for (int idx = tid; idx < 64 * 128; idx += NTHREADS) { int kk = idx >> 7, cc = idx & 127; Wt[idx] = src[(size_t)(k0 + kk) * DIN + cc]; }
    if (tid < 128) { double s, c; dsincos(6.283185307179586476925286766559 * (double)tid / 128.0, s, c); ct[tid] = (float)c; ct[128 + tid] = (float)s; }
    __syncthreads();
    const int k2 = tid & 127, part = tid >> 7;
    bf16* dst = (bf16*)(P.ws + OFF_WIN) + boff(2304 + part * 512 + g * 128 + k2, k0, D);
    for (int kk = 0; kk < 64; kk += 8) {
        float a[8];
#pragma unroll
        for (int u = 0; u < 8; ++u) a[u] = 0.f;
        for (int c = 0; c < 128; ++c) {
            int m = (c * k2) & 127;
            float tw = part ? -ct[128 + m] : ct[m];
#pragma unroll
            for (int u = 0; u < 8; ++u) a[u] += Wt[(kk + u) * 128 + c] * tw;
        }
        v4u o; o.x = pk2(a[0], a[1]); o.y = pk2(a[2], a[3]); o.z = pk2(a[4], a[5]); o.w = pk2(a[6], a[7]);
        *(v4u*)(dst + (kk >> 5) * 512 + (kk & 31)) = o;
    }
}

DEVI void mod_item(const Params& P, int it, unsigned char* smem) {
    const int tid = ltid(), lane = tid & 63, w = tid >> 6;
    const int l = it / 144, n0 = (it - l * 144) * 64;
    float* sc = (float*)smem;
    float* red = sc + 3 * 1024;
    __syncthreads();
    for (int i = tid; i < 3 * 1024; i += NTHREADS) {
        int r = i >> 10, k = i & 1023;
        float v = r < 2 ? P.c[r * D + k] : P.c_ctx[k];
        sc[i] = siluf_(v);
    }
    __syncthreads();
    const float* wsrc = P.w_mod + (size_t)l * D * NMOD + n0 + lane;
    float a0 = 0.f, a1 = 0.f, a2 = 0.f;
#pragma unroll 8
    for (int k = w * 256; k < w * 256 + 256; ++k) {
        float wv = wsrc[(size_t)k * NMOD];
        a0 += sc[k] * wv; a1 += sc[1024 + k] * wv; a2 += sc[2048 + k] * wv;
    }
    red[(w * 3 + 0) * 64 + lane] = a0; red[(w * 3 + 1) * 64 + lane] = a1; red[(w * 3 + 2) * 64 + lane] = a2;
    __syncthreads();
    if (tid < 192) {
        int r = tid >> 6;
        float s = red[(0 * 3 + r) * 64 + lane] + red[(1 * 3 + r) * 64 + lane] + red[(2 * 3 + r) * 64 + lane] + red[(3 * 3 + r) * 64 + lane];
        float* MOD = (float*)(P.ws + OFF_MOD);
        MOD[(size_t)(l * 3 + r) * NMOD + n0 + lane] = s + P.b_mod[(size_t)l * NMOD + n0 + lane];
    }
}

DEVI void tables_item(const Params& P) {
    const int tid = ltid();
    float* RT = (float*)(P.ws + OFF_ROPE);
    float* TW = (float*)(P.ws + OFF_TW);
    for (int i = tid; i < 1024; i += NTHREADS) {
        int p = i >> 3, f = i & 7;
        float fv = f == 0 ? 1.0f : f == 1 ? 0.31622776601683794f : f == 2 ? 0.1f : f == 3 ? 0.03162277660168379f : f == 4 ? 0.01f : f == 5 ? 0.0031622776601683794f : f == 6 ? 0.001f : 0.00031622776601683794f;
        float ang = (float)p * fv;
        double s, c; dsincos((double)ang, s, c);
        RT[i * 2] = (float)c; RT[i * 2 + 1] = (float)s;
    }
    for (int m = tid; m < 4096; m += NTHREADS) {
        double s, c; dsincos(6.283185307179586476925286766559 * (double)m / 8192.0, s, c);
        TW[m * 2] = (float)c; TW[m * 2 + 1] = (float)s;
    }
}

DEVI void prep_phase(const Params& P, int l, bool first, unsigned char* smem) {
    const int n_mod = first ? 288 : 0, n_tab = first ? 1 : 0, n_fold = 64;
    const int total = n_mod + n_tab + n_fold + N_TR_BLOCK_ITEMS;
    const int lane = ltid() & 63, w = ltid() >> 6;
    FOR_ITEMS(it, total) {
        int r = it;
        if (r < n_mod) { mod_item(P, r, smem); continue; }
        r -= n_mod;
        if (r < n_tab) { tables_item(P); continue; }
        r -= n_tab;
        if (r < n_fold) { fold_item(P, l, r, smem); continue; }
        r -= n_fold;
        __syncthreads();
        transpose_dispatch(P, l, r * 4 + w, (float*)smem + w * (64 * 33), lane);
    }
}

DEVI void norm_phase(const Params& P, int nrows, bool first_x, bool has_res, float rscale, const float* g_post, const float* mod_res  , int gate_chunk,
                     bool has_h, const float* g_pre, const float* mod_h, int shift_chunk) {
    const int lane = ltid() & 63, w = ltid() >> 6;
    const bf16* Y = (const bf16*)(P.ws + OFF_Y);
    bf16* H = (bf16*)(P.ws + OFF_H);
    float* XC = (float*)(P.ws + OFF_XC);
    f32x4 cr[4], ch[4], cs[4];
    int cur = -1;
    for (int r = lbid() * 4 + w; r < nrows; r += gridDim.x * 4) {
        const bool lat = r < ML;
        const int mrow = lat ? (r >> 13) : 2;
        if (mrow != cur) {
            cur = mrow;
#pragma unroll
            for (int j = 0; j < 4; ++j) {
                const int c = 4 * lane + 256 * j;
                if (has_res) {
                    f32x4 gp = *(const f32x4*)(g_post + c);
                    f32x4 gt = *(const f32x4*)(mod_res + (size_t)mrow * NMOD + gate_chunk * D + c);
                    cr[j] = (f32x4){gt.x * gp.x * rscale, gt.y * gp.y * rscale, gt.z * gp.z * rscale, gt.w * gp.w * rscale};
                }
                if (has_h) {
                    f32x4 gp = *(const f32x4*)(g_pre + c);
                    f32x4 sh = *(const f32x4*)(mod_h + (size_t)mrow * NMOD + shift_chunk * D + c);
                    f32x4 sc = *(const f32x4*)(mod_h + (size_t)mrow * NMOD + (shift_chunk + 1) * D + c);
                    ch[j] = (f32x4){gp.x * (1.f + sc.x), gp.y * (1.f + sc.y), gp.z * (1.f + sc.z), gp.w * (1.f + sc.w)};
                    cs[j] = sh;
                }
            }
        }
        const float* xin = lat ? ((first_x ? P.x : P.out) + (size_t)r * D) : ((first_x ? P.ctx : XC) + (size_t)(r - ML) * D);
        float* xout = lat ? (P.out + (size_t)r * D) : (XC + (size_t)(r - ML) * D);
        f32x4 v[4];
#pragma unroll
        for (int j = 0; j < 4; ++j) v[j] = *(const f32x4*)(xin + 4 * lane + 256 * j);
        if (has_res) {
            f32x4 y[4];
            float ss = 0.f;
#pragma unroll
            for (int j = 0; j < 4; ++j) {
                v2u u = *(const v2u*)(Y + (size_t)r * D + 4 * lane + 256 * j);
                y[j] = (f32x4){bflo(u.x), bfhi(u.x), bflo(u.y), bfhi(u.y)};
                ss += y[j].x * y[j].x + y[j].y * y[j].y + y[j].z * y[j].z + y[j].w * y[j].w;
            }
#pragma unroll
            for (int o = 1; o < 64; o <<= 1) ss += __shfl_xor(ss, o);
            const float rs = rsqrtf(ss * (1.f / D) + EPS);
#pragma unroll
            for (int j = 0; j < 4; ++j) {
                v[j].x += cr[j].x * (y[j].x * rs); v[j].y += cr[j].y * (y[j].y * rs);
                v[j].z += cr[j].z * (y[j].z * rs); v[j].w += cr[j].w * (y[j].w * rs);
                *(f32x4*)(xout + 4 * lane + 256 * j) = v[j];
            }
        }
        if (has_h) {
            float ss = 0.f;
#pragma unroll
            for (int j = 0; j < 4; ++j) ss += v[j].x * v[j].x + v[j].y * v[j].y + v[j].z * v[j].z + v[j].w * v[j].w;
#pragma unroll
            for (int o = 1; o < 64; o <<= 1) ss += __shfl_xor(ss, o);
            const float rs = rsqrtf(ss * (1.f / D) + EPS);
#pragma unroll
            for (int j = 0; j < 4; ++j) {
                v2u o;
                o.x = pk2(v[j].x * rs * ch[j].x + cs[j].x, v[j].y * rs * ch[j].y + cs[j].y);
                o.y = pk2(v[j].z * rs * ch[j].z + cs[j].z, v[j].w * rs * ch[j].w + cs[j].w);
                *(v2u*)(H + boff(r, 4 * lane + 256 * j, D)) = o;
            }
        }
    }
}

#define EPI_COORDS const int tid = ltid(), lane = tid & 63, wid = tid >> 6, wr = wid >> 1, wc = wid & 1, fr = lane & 15, fq = lane >> 4; (void)tid; (void)wr; (void)wc; (void)fr; (void)fq;

DEVI void gemm_gu_phase(const Params& P, int j, int mtiles, unsigned char* smem) {
    EPI_COORDS
    const bf16* A = (const bf16*)(P.ws + OFF_H);
    const bf16* Bt = (const bf16*)(P.ws + OFF_WGU) + (size_t)j * NGU * D;
    bf16* ACT = (bf16*)(P.ws + OFF_BIG);
    const int NT = NGU / 128, total = mtiles * NT;
    FOR_ITEMS(L, total) {
        int tm, tn; tile_map(L, mtiles, NT, tm, tn);
        f32x4 acc[8][4]; zero_acc<8>(acc);
        gemm_ml<8, 3, true>(A, D, Bt, D, D, tm * 256, tn * 128, smem, acc);
#pragma unroll
        for (int m = 0; m < 8; ++m)
#pragma unroll
            for (int n = 0; n < 2; ++n) {
                int row = tm * 256 + wr * 128 + m * 16 + fr;
                int col = tn * 64 + wc * 32 + n * 16 + fq * 4;
                v2u o;
                o.x = pk2(siluf_(acc[m][n][0]) * acc[m][n + 2][0], siluf_(acc[m][n][1]) * acc[m][n + 2][1]);
                o.y = pk2(siluf_(acc[m][n][2]) * acc[m][n + 2][2], siluf_(acc[m][n][3]) * acc[m][n + 2][3]);
                *(v2u*)(ACT + boff(row, col, DFF)) = o;
            }
    }
}
template <int MB>
DEVI void plain_tile(const bf16* A, int lda, const bf16* Bt, int K, bf16* C, int ldc, int row0, int col0, unsigned char* smem) {
    EPI_COORDS
    f32x4 acc[MB][4]; zero_acc<MB>(acc);
    gemm_ml<MB, 3, true>(A, lda, Bt, K, K, row0, col0, smem, acc);
#pragma unroll
    for (int m = 0; m < MB; ++m)
#pragma unroll
        for (int n = 0; n < 4; ++n) {
            int row = row0 + wr * (MB * 16) + m * 16 + fr;
            int col = col0 + wc * 64 + n * 16 + fq * 4;
            v2u o; o.x = pk2(acc[m][n][0], acc[m][n][1]); o.y = pk2(acc[m][n][2], acc[m][n][3]);
            *(v2u*)(C + (size_t)row * ldc + col) = o;
        }
}
DEVI void gemm_plain_phase(const bf16* A, int lda, const bf16* Bt, int K, bf16* C, int ldc, int rows_big, int rows_small, unsigned char* smem) {
    const int NT = 8, mtb = rows_big / 256, nbig = mtb * NT, total = nbig + (rows_small / 64) * NT;
    FOR_ITEMS(L, total) {
        if (L < nbig) { int tm, tn; tile_map(L, mtb, NT, tm, tn); plain_tile<8>(A, lda, Bt, K, C, ldc, tm * 256, tn * 128, smem); }
        else { int r = L - nbig; plain_tile<2>(A, lda, Bt, K, C, ldc, rows_big + (r >> 3) * 64, (r & 7) * 128, smem); }
    }
}
DEVI float rope_apply(float v, int fr, int p, const float* RT) {
    asm volatile("" : "+v"(p));
    float partner = __shfl_xor(v, 8);
    const float cs = RT[(p * 8 + (fr & 7)) * 2], sn = RT[(p * 8 + (fr & 7)) * 2 + 1];
    return (fr & 8) ? (v * cs + partner * sn) : (v * cs - partner * sn);
}
DEVI void gemm_win_phase(const Params& P, unsigned char* smem) {
    EPI_COORDS
    const bf16* A = (const bf16*)(P.ws + OFF_H);
    const bf16* Bt = (const bf16*)(P.ws + OFF_WIN);
    bf16* Z = (bf16*)(P.ws + OFF_BIG);
    bf16* PT = (bf16*)(P.ws + OFF_Y);
    bf16* KF = (bf16*)(P.ws + OFF_K);
    const float* RT = (const float*)(P.ws + OFF_ROPE);
    const int NT = NWIN / 128, MTL = MT / 256, total = MTL * NT;
    FOR_ITEMS(L, total) {
        int tm, tn; tile_map(L, MTL, NT, tm, tn);
        f32x4 acc[8][4]; zero_acc<8>(acc);
        gemm_ml<8, 3>(A, D, Bt, D, D, tm * 256, tn * 128, smem, acc);
        const int row0 = tm * 256;
        const bool lat = row0 < ML;
        const int b = lat ? (row0 >> 13) : ((row0 - ML) >> 8);
        const int pos0 = lat ? (row0 & (SEQ - 1)) : (SEQ + ((row0 - ML) & (CTXL - 1)));
        if (tn >= 4 && tn < 8) {
            bf16* GVT = (bf16*)(P.ws + OFF_GVT);
#pragma unroll
            for (int m = 0; m < 8; ++m)
#pragma unroll
                for (int n = 0; n < 4; ++n) {
                    int e = wc * 64 + n * 16 + fr;
                    int pos = pos0 + wr * 128 + m * 16 + fq * 4;
                    v2u o; o.x = pk2(acc[m][n][0], acc[m][n][1]); o.y = pk2(acc[m][n][2], acc[m][n][3]);
                    *(v2u*)(GVT + ((size_t)((b * 4 + tn - 4) * 128 + e)) * NPOS + pos) = o;
                }
        } else if (tn < 17) {
#pragma unroll
            for (int m = 0; m < 8; ++m)
#pragma unroll
                for (int n = 0; n < 4; ++n)
#pragma unroll
                    for (int jj = 0; jj < 4; ++jj) {
                        int row = row0 + wr * 128 + m * 16 + fq * 4 + jj;
                        int col = tn * 128 + wc * 64 + n * 16 + fr;
                        Z[(size_t)row * NZ + col] = (bf16)f2bf(acc[m][n][jj]);
                    }
        } else if (tn == 17) {
            if (wc == 0) {
#pragma unroll
                for (int m = 0; m < 8; ++m)
#pragma unroll
                    for (int jj = 0; jj < 4; ++jj) {
                        int lr = wr * 128 + m * 16 + fq * 4 + jj;
                        int row = row0 + lr, pos = pos0 + lr;
#pragma unroll
                        for (int n = 0; n < 2; ++n) Z[(size_t)row * NZ + 2176 + n * 16 + fr] = (bf16)f2bf(acc[m][n][jj]);
                        float v2 = acc[m][2][jj], v3 = acc[m][3][jj];
                        if (lat) { v2 = rope_apply(v2, fr, pos >> 6, RT); v3 = rope_apply(v3, fr, pos & 63, RT); }
                        bf16 h2 = (bf16)f2bf(v2), h3 = (bf16)f2bf(v3);
#pragma unroll
                        for (int h = 0; h < 8; ++h) {
                            bf16* kd = KF + ((size_t)(b * 8 + h) * NPOS + pos) * 96 + 64;
                            kd[fr] = h2; kd[16 + fr] = h3;
                        }
                    }
            }
        } else {
            const int c0 = (tn - 18) * 128 + wc * 64;
#pragma unroll
            for (int m = 0; m < 8; ++m)
#pragma unroll
                for (int n = 0; n < 4; ++n) {
                    int c = c0 + n * 16 + fr;
                    int pos = pos0 + wr * 128 + m * 16 + fq * 4;
                    v2u o; o.x = pk2(acc[m][n][0], acc[m][n][1]); o.y = pk2(acc[m][n][2], acc[m][n][3]);
                    *(v2u*)(PT + ((size_t)(b * 1024 + c)) * NPOS + pos) = o;
                }
        }
    }
}

DEVI void row_rms(const bf16* A, int lda, int K, int row0, float* rsc) {
    const int tid = ltid();
    const int r = tid >> 1, hf = tid & 1;
    const bf16* p = A + (size_t)(row0 + r) * lda + hf * (K / 2);
    float ss = 0.f;
    for (int k = 0; k < K / 2; k += 8) {
        v4u u = *(const v4u*)(p + k);
        float a;
        a = bflo(u.x); ss += a * a; a = bfhi(u.x); ss += a * a; a = bflo(u.y); ss += a * a; a = bfhi(u.y); ss += a * a;
        a = bflo(u.z); ss += a * a; a = bfhi(u.z); ss += a * a; a = bflo(u.w); ss += a * a; a = bfhi(u.w); ss += a * a;
    }
    ss += __shfl_xor(ss, 1);
    if (hf == 0) rsc[r] = rsqrtf(ss / (float)K + EPS);
}

DEVI void mla_q_tile(const Params& P, int tm, int tn, unsigned char* smem) {
    EPI_COORDS
    const bf16* Z = (const bf16*)(P.ws + OFF_BIG);
    bf16* Q = (bf16*)(P.ws + OFF_Q);
    const float* RT = (const float*)(P.ws + OFF_ROPE);
    float* rsc = (float*)(smem + 49152);
    const int row0 = tm * 128;
    __syncthreads();
    row_rms(Z + 1536, NZ, 384, row0, rsc);
    f32x4 acc[4][4]; zero_acc<4>(acc);
    gemm_ml<4, 3, false, false>(Z + 1536, NZ, (const bf16*)(P.ws + OFF_WUQ), 384, 384, row0, tn * 128, smem, acc);
    const bool lat = row0 < ML;
    const int b = lat ? (row0 >> 13) : ((row0 - ML) >> 8);
    const int pos0 = lat ? (row0 & (SEQ - 1)) : (SEQ + ((row0 - ML) & (CTXL - 1)));
    const float qs = 0.10206207261596575f * 1.4426950408889634f;
#pragma unroll
    for (int n = 0; n < 4; ++n) {
        const int c16 = tn * 128 + wc * 64 + n * 16;
        const int h = c16 / 96, d0 = c16 - h * 96;
#pragma unroll
        for (int m = 0; m < 4; ++m)
#pragma unroll
            for (int jj = 0; jj < 4; ++jj) {
                int lr = wr * 64 + m * 16 + fq * 4 + jj;
                int pos = pos0 + lr;
                float v = acc[m][n][jj] * rsc[lr];
                if (lat && d0 >= 64) v = rope_apply(v, fr, d0 == 64 ? (pos >> 6) : (pos & 63), RT);
                Q[((size_t)(b * 8 + h) * NPOS + pos) * 96 + d0 + fr] = (bf16)f2bf(v * qs);
            }
    }
}
DEVI void mla_kv_tile(const Params& P, int tm, int tn, unsigned char* smem) {
    EPI_COORDS
    const bf16* Z = (const bf16*)(P.ws + OFF_BIG);
    bf16* KF = (bf16*)(P.ws + OFF_K);
    bf16* VT = (bf16*)(P.ws + OFF_VT);
    float* rsc = (float*)(smem + 49152);
    const int row0 = tm * 128;
    __syncthreads();
    row_rms(Z + 1920, NZ, 256, row0, rsc);
    f32x4 acc[4][4]; zero_acc<4>(acc);
    gemm_ml<4, 3, false, false>(Z + 1920, NZ, (const bf16*)(P.ws + OFF_WUKV), 256, 256, row0, tn * 128, smem, acc);
    const bool lat = row0 < ML;
    const int b = lat ? (row0 >> 13) : ((row0 - ML) >> 8);
    const int pos0 = lat ? (row0 & (SEQ - 1)) : (SEQ + ((row0 - ML) & (CTXL - 1)));
    const int h = tn;
    if (wc == 0) {
#pragma unroll
        for (int m = 0; m < 4; ++m)
#pragma unroll
            for (int n = 0; n < 4; ++n)
#pragma unroll
                for (int jj = 0; jj < 4; ++jj) {
                    int lr = wr * 64 + m * 16 + fq * 4 + jj;
                    KF[((size_t)(b * 8 + h) * NPOS + pos0 + lr) * 96 + n * 16 + fr] = (bf16)f2bf(acc[m][n][jj] * rsc[lr]);
                }
    } else {
#pragma unroll
        for (int m = 0; m < 4; ++m)
#pragma unroll
            for (int n = 0; n < 4; ++n) {
                int lr = wr * 64 + m * 16 + fq * 4;
                v2u o; o.x = pk2(acc[m][n][0] * rsc[lr], acc[m][n][1] * rsc[lr + 1]); o.y = pk2(acc[m][n][2] * rsc[lr + 2], acc[m][n][3] * rsc[lr + 3]);
                *(v2u*)(VT + ((size_t)(b * 8 + h) * 64 + n * 16 + fr) * NPOS + pos0 + lr) = o;
            }
    }
}

DEVI void fft_item(const bf16* re_src, const bf16* im_src, int N, bf16* dst, int dst_stride, float scale, const float* TW, unsigned char* smem) {
    const int tid = ltid();
    float* re = (float*)smem;
    float* im = re + 8192;
    __syncthreads();
    for (int i = tid; i < N / 8; i += NTHREADS) {
        v4u a = *(const v4u*)(re_src + i * 8), b = *(const v4u*)(im_src + i * 8);
        float* r = re + i * 8; float* q = im + i * 8;
        r[0] = bflo(a.x); r[1] = bfhi(a.x); r[2] = bflo(a.y); r[3] = bfhi(a.y); r[4] = bflo(a.z); r[5] = bfhi(a.z); r[6] = bflo(a.w); r[7] = bfhi(a.w);
        q[0] = bflo(b.x); q[1] = bfhi(b.x); q[2] = bflo(b.y); q[3] = bfhi(b.y); q[4] = bflo(b.z); q[5] = bfhi(b.z); q[6] = bflo(b.w); q[7] = bfhi(b.w);
    }
    __syncthreads();
    const int t4 = N >> 2;
    int p = 1;
    for (; p * 4 <= N; p <<= 2) {
        float xr[8][4], xi[8][4];
#pragma unroll
        for (int u = 0; u < 8; ++u) {
            const int i = tid + NTHREADS * u;
#pragma unroll
            for (int r = 0; r < 4; ++r) {
                if (i < t4) { xr[u][r] = re[i + r * t4]; xi[u][r] = im[i + r * t4]; }
                else { xr[u][r] = 0.f; xi[u][r] = 0.f; }
            }
        }
        __syncthreads();
        const float inv4p = 0.25f / (float)p;
        const bool hoist = (p <= NTHREADS);
        const float rev_h = (float)(tid & (p - 1)) * inv4p;
        const float c_h = __builtin_amdgcn_cosf(rev_h), s_h = __builtin_amdgcn_sinf(rev_h);
#pragma unroll
        for (int u = 0; u < 8; ++u) {
            const int i = tid + NTHREADS * u;
            if (i < t4) {
                const int k = i & (p - 1);
                const int j = ((i - k) << 2) + k;
                float w1r = c_h, w1i = -s_h;
                if (!hoist) { const float rev = (float)k * inv4p; w1r = __builtin_amdgcn_cosf(rev); w1i = -__builtin_amdgcn_sinf(rev); }
                const float w2r = w1r * w1r - w1i * w1i, w2i = 2.f * w1r * w1i;
                const float w3r = w2r * w1r - w2i * w1i, w3i = w2r * w1i + w2i * w1r;
                const float u0r = xr[u][0], u0i = xi[u][0];
                const float u1r = xr[u][1] * w1r - xi[u][1] * w1i, u1i = xr[u][1] * w1i + xi[u][1] * w1r;
                const float u2r = xr[u][2] * w2r - xi[u][2] * w2i, u2i = xr[u][2] * w2i + xi[u][2] * w2r;
                const float u3r = xr[u][3] * w3r - xi[u][3] * w3i, u3i = xr[u][3] * w3i + xi[u][3] * w3r;
                const float v0r = u0r + u2r, v0i = u0i + u2i, v1r = u0r - u2r, v1i = u0i - u2i;
                const float v2r = u1r + u3r, v2i = u1i + u3i, dr = u1r - u3r, di = u1i - u3i;
                const float v3r = di, v3i = -dr;
                re[j] = v0r + v2r;         im[j] = v0i + v2i;
                re[j + p] = v1r + v3r;     im[j + p] = v1i + v3i;
                re[j + 2 * p] = v0r - v2r; im[j + 2 * p] = v0i - v2i;
                re[j + 3 * p] = v1r - v3r; im[j + 3 * p] = v1i - v3i;
            }
        }
        __syncthreads();
    }
    if (p < N) {
        const int half = N >> 1;
        float ar[16], ai[16], br[16], bi[16];
#pragma unroll
        for (int u = 0; u < 16; ++u) {
            int i = tid + NTHREADS * u;
            if (i < half) { ar[u] = re[i]; ai[u] = im[i]; br[u] = re[i + half]; bi[u] = im[i + half]; }
            else { ar[u] = 0.f; ai[u] = 0.f; br[u] = 0.f; bi[u] = 0.f; }
        }
        __syncthreads();
        const float inv2p = 0.5f / (float)p;
#pragma unroll
        for (int u = 0; u < 16; ++u) {
            int i = tid + NTHREADS * u;
            if (i < half) {
                int k = i & (p - 1);
                int j = ((i - k) << 1) + k;
                const float rev = (float)k * inv2p;
                const float c = __builtin_amdgcn_cosf(rev), sn = __builtin_amdgcn_sinf(rev);
                float xr2 = br[u] * c + bi[u] * sn, xi2 = bi[u] * c - br[u] * sn;
                re[j] = ar[u] + xr2; im[j] = ai[u] + xi2; re[j + p] = ar[u] - xr2; im[j + p] = ai[u] - xi2;
            }
        }
        __syncthreads();
    }
    (void)dst_stride;
    for (int i = tid * 8; i < N; i += NTHREADS * 8) {
        const float* r = re + i;
        v4u o; o.x = pk2(r[0] * scale, r[1] * scale); o.y = pk2(r[2] * scale, r[3] * scale); o.z = pk2(r[4] * scale, r[5] * scale); o.w = pk2(r[6] * scale, r[7] * scale);
        *(v4u*)(dst + i) = o;
    }
}

DEVI void ybt_transpose_item(const Params& P, int it, unsigned char* smem) {
    const int tid = ltid();
    int b, pos0, c0;
    if (it < 2048) { b = it >> 10; pos0 = ((it >> 3) & 127) * 64; c0 = (it & 7) * 64; }
    else { int r = it - 2048; b = r >> 5; pos0 = SEQ + ((r >> 3) & 3) * 64; c0 = (r & 7) * 64; }
    const bf16* PT = (const bf16*)(P.ws + OFF_Y);
    bf16* YB = (bf16*)(P.ws + OFF_YB);
    bf16* T = (bf16*)smem;
    __syncthreads();
#pragma unroll
    for (int i = 0; i < 2; ++i) {
        int ch = tid + NTHREADS * i;
        int c = ch >> 3, p8 = (ch & 7) * 8;
        v4u u = *(const v4u*)(PT + ((size_t)(b * 1024 + c0 + c)) * NPOS + pos0 + p8);
        T[(p8 + 0) * 72 + c] = (bf16)(u.x & 0xffff); T[(p8 + 1) * 72 + c] = (bf16)(u.x >> 16);
        T[(p8 + 2) * 72 + c] = (bf16)(u.y & 0xffff); T[(p8 + 3) * 72 + c] = (bf16)(u.y >> 16);
        T[(p8 + 4) * 72 + c] = (bf16)(u.z & 0xffff); T[(p8 + 5) * 72 + c] = (bf16)(u.z >> 16);
        T[(p8 + 6) * 72 + c] = (bf16)(u.w & 0xffff); T[(p8 + 7) * 72 + c] = (bf16)(u.w >> 16);
    }
    __syncthreads();
#pragma unroll
    for (int i = 0; i < 2; ++i) {
        int ch = tid + NTHREADS * i;
        int p = ch >> 3, c8 = (ch & 7) * 8;
        v4u u = *(const v4u*)(T + p * 72 + c8);
        *(v4u*)(YB + boff(row_of_pos(b, pos0 + p), c0 + c8, 512)) = u;
    }
}


template <int MB, int NBk>
DEVI void wave_mma(const bf16* As, int sa, const bf16* Bs, int sb, int K, f32x4 (&acc)[MB][NBk]) {
    const int lane = ltid() & 63, fr = lane & 15, fq = lane >> 4;
    for (int k = 0; k < K; k += 32) {
        bf16x8 a[MB], b[NBk];
#pragma unroll
        for (int m = 0; m < MB; ++m) a[m] = *(const bf16x8*)(As + (m * 16 + fr) * sa + k + fq * 8);
#pragma unroll
        for (int n = 0; n < NBk; ++n) b[n] = *(const bf16x8*)(Bs + (n * 16 + fr) * sb + k + fq * 8);
#pragma unroll
        for (int m = 0; m < MB; ++m)
#pragma unroll
            for (int n = 0; n < NBk; ++n) acc[m][n] = __builtin_amdgcn_mfma_f32_16x16x32_bf16(a[m], b[n], acc[m][n], 0, 0, 0);
    }
}

DEVI int gla_row_base(int b, int dir, int cp) {
    if (cp < 4) { int c = dir ? 3 - cp : cp; return ML + b * CTXL + c * 64; }
    int c = dir ? 131 - cp : cp - 4;
    return b * SEQ + c * 64;
}
DEVI void gla_cumsum(const Params& P, int l, const bf16* Z, int row0, int h, int dir, float* cum, float* abuf) {
    const int tid = ltid();
    for (int i = tid; i < 64 * 16; i += NTHREADS) { int t = i >> 4, r = i & 15; abuf[i] = bf2f(Z[(size_t)(row0 + t) * NZ + 2176 + dir * 16 + r]); }
    __syncthreads();
    const int d = tid & 63, q = tid >> 6;
    float* qtot = abuf + 1024;
    {
        const float* wd = P.gla_wdec + ((size_t)(l * 2 + dir) * 16) * 256 + h * 64 + d;
        float w[16];
#pragma unroll
        for (int r = 0; r < 16; ++r) w[r] = wd[r * 256];
        const float bb = P.gla_bdec[(l * 2 + dir) * 256 + h * 64 + d];
        float run = 0.f;
#pragma unroll 4
        for (int tt = 0; tt < 16; ++tt) {
            const int t = q * 16 + (dir ? 15 - tt : tt);
            const f32x4* ar = (const f32x4*)(abuf + t * 16);
            f32x4 a0 = ar[0], a1 = ar[1], a2 = ar[2], a3 = ar[3];
            float x = bb + a0.x * w[0] + a0.y * w[1] + a0.z * w[2] + a0.w * w[3] + a1.x * w[4] + a1.y * w[5] + a1.z * w[6] + a1.w * w[7]
                      + a2.x * w[8] + a2.y * w[9] + a2.z * w[10] + a2.w * w[11] + a3.x * w[12] + a3.y * w[13] + a3.z * w[14] + a3.w * w[15];
            run += logsigmoidf_(x) * (1.f / 16.f);
            cum[t * 64 + d] = run;
        }
        qtot[q * 64 + d] = run;
    }
    __syncthreads();
    {
        float off = 0.f;
        if (dir == 0) { for (int qq = 0; qq < q; ++qq) off += qtot[qq * 64 + d]; }
        else { for (int qq = 3; qq > q; --qq) off += qtot[qq * 64 + d]; }
#pragma unroll 4
        for (int tt = 0; tt < 16; ++tt) cum[(q * 16 + tt) * 64 + d] += off;
    }
    __syncthreads();
}
constexpr int GS = 72;
DEVI void gla_load_vt(const Params& P, int b, int h, int pos0, bf16* VTs) {
    const int tid = ltid();
    const bf16* G = (const bf16*)(P.ws + OFF_GVT) + (size_t)((b * 4 + h) * 128) * NPOS + pos0;
#pragma unroll
    for (int i = 0; i < 4; ++i) {
        int c = tid + NTHREADS * i;
        int e = c >> 3, part = c & 7;
        *(v4u*)(VTs + e * GS + part * 8) = *(const v4u*)(G + (size_t)e * NPOS + part * 8);
    }
}
DEVI void gla_local_item(const Params& P, int l, int it, unsigned char* smem) {
    const int tid = ltid(), lane = tid & 63, w = tid >> 6, fr = lane & 15, fq = lane >> 4;
    const int chain = it / 132, cp = it - chain * 132;
    const int b = chain >> 3, h = (chain >> 1) & 3, dir = chain & 1;
    const int row0 = gla_row_base(b, dir, cp);
    const bf16* Z = (const bf16*)(P.ws + OFF_BIG);
    float* cum = (float*)smem;
    bf16* VTs = (bf16*)(smem + 16384);
    bf16* KTs = (bf16*)(smem + 16384 + 128 * GS * 2);
    float* abuf = (float*)(smem + 16384 + 192 * GS * 2);
    __syncthreads();
    gla_cumsum(P, l, Z, row0, h, dir, cum, abuf);
    gla_load_vt(P, b, h, row0 < ML ? (row0 & (SEQ - 1)) : SEQ + ((row0 - ML) & (CTXL - 1)), VTs);
    const int tl = dir ? 0 : 63;
#pragma unroll
    for (int i = 0; i < 2; ++i) {
        int c = tid + NTHREADS * i;
        int s = c >> 3, d0 = (c & 7) * 8;
        v4u u = *(const v4u*)(Z + (size_t)(row0 + s) * NZ + 256 + h * 64 + d0);
        float kv[8] = {bflo(u.x), bfhi(u.x), bflo(u.y), bfhi(u.y), bflo(u.z), bfhi(u.z), bflo(u.w), bfhi(u.w)};
#pragma unroll
        for (int q = 0; q < 8; ++q) KTs[(d0 + q) * GS + s] = (bf16)f2bf(kv[q] * __expf(cum[tl * 64 + d0 + q] - cum[s * 64 + d0 + q]));
    }
    if (tid < 64) ((float*)(P.ws + OFF_DEC))[(size_t)(chain * 132 + cp) * 64 + tid] = __expf(cum[tl * 64 + tid]);
    __syncthreads();
    f32x4 acc[2][4];
#pragma unroll
    for (int m = 0; m < 2; ++m)
#pragma unroll
        for (int n = 0; n < 4; ++n) acc[m][n] = (f32x4){0.f, 0.f, 0.f, 0.f};
    wave_mma<2, 4>(VTs + (w * 32) * GS, GS, KTs, GS, 64, acc);
    bf16* ST = (bf16*)(P.ws + OFF_Y) + (size_t)(chain * 132 + cp) * 8192;
#pragma unroll
    for (int m = 0; m < 2; ++m)
#pragma unroll
        for (int n = 0; n < 4; ++n)
#pragma unroll
            for (int jj = 0; jj < 4; ++jj) ST[(w * 32 + m * 16 + fq * 4 + jj) * 64 + n * 16 + fr] = (bf16)f2bf(acc[m][n][jj]);
}
DEVI void gla_scan_phase(const Params& P) {
    bf16* ST = (bf16*)(P.ws + OFF_Y);
    const float* DEC = (const float*)(P.ws + OFF_DEC);
    for (int g = lbid() * NTHREADS + ltid(); g < 16 * 2048; g += gridDim.x * NTHREADS) {
        const int chain = g >> 11, idx = (g & 2047) * 4, d = idx & 63;
        bf16* p = ST + (size_t)chain * 132 * 8192 + idx;
        const float* dc = DEC + (size_t)chain * 132 * 64 + d;
        float S0 = 0.f, S1 = 0.f, S2 = 0.f, S3 = 0.f;
        for (int c0 = 0; c0 < 132; c0 += 12) {
            v2u Lv[12]; f32x4 dv[12];
#pragma unroll
            for (int u = 0; u < 12; ++u) { Lv[u] = *(const v2u*)(p + (size_t)(c0 + u) * 8192); dv[u] = *(const f32x4*)(dc + (c0 + u) * 64); }
#pragma unroll
            for (int u = 0; u < 12; ++u) {
                v2u o; o.x = pk2(S0, S1); o.y = pk2(S2, S3);
                *(v2u*)(p + (size_t)(c0 + u) * 8192) = o;
                S0 = dv[u].x * S0 + bflo(Lv[u].x); S1 = dv[u].y * S1 + bfhi(Lv[u].x);
                S2 = dv[u].z * S2 + bflo(Lv[u].y); S3 = dv[u].w * S3 + bfhi(Lv[u].y);
            }
        }
    }
}
DEVI void gla_out_item(const Params& P, int l, int it, bool skip_ctx, unsigned char* smem) {
    const int tid = ltid(), lane = tid & 63, w = tid >> 6, fr = lane & 15, fq = lane >> 4;
    const int bh = it / 132, ci = it - bh * 132;
    if (skip_ctx && ci < 4) return;
    const int b = bh >> 2, h = bh & 3;
    const int row0 = ci < 4 ? ML + b * CTXL + ci * 64 : b * SEQ + (ci - 4) * 64;
    const bf16* Z = (const bf16*)(P.ws + OFF_BIG);
    float* cum = (float*)smem;
    bf16* Pw = (bf16*)smem + w * 16 * GS;
    bf16* QA = (bf16*)(smem + 16384);
    bf16* KB = QA + 64 * GS;
    bf16* VTs = KB + 64 * GS;
    float* abuf = (float*)(smem + 16384 + 256 * GS * 2);
    f32x4 O[1][8];
#pragma unroll
    for (int n = 0; n < 8; ++n) O[0][n] = (f32x4){0.f, 0.f, 0.f, 0.f};
    __syncthreads();
    gla_load_vt(P, b, h, ci < 4 ? SEQ + ci * 64 : (ci - 4) * 64, VTs);
    for (int dir = 0; dir < 2; ++dir) {
        const int chain = (b * 4 + h) * 2 + dir;
        const int cp = dir ? (ci < 4 ? 3 - ci : 135 - ci) : ci;
        gla_cumsum(P, l, Z, row0, h, dir, cum, abuf);
#pragma unroll
        for (int i = 0; i < 2; ++i) {
            int c = tid + NTHREADS * i;
            int s = c >> 3, d0 = (c & 7) * 8;
            v4u uq = *(const v4u*)(Z + (size_t)(row0 + s) * NZ + h * 64 + d0);
            v4u uk = *(const v4u*)(Z + (size_t)(row0 + s) * NZ + 256 + h * 64 + d0);
            float qv[8] = {bflo(uq.x), bfhi(uq.x), bflo(uq.y), bfhi(uq.y), bflo(uq.z), bfhi(uq.z), bflo(uq.w), bfhi(uq.w)};
            float kv[8] = {bflo(uk.x), bfhi(uk.x), bflo(uk.y), bfhi(uk.y), bflo(uk.z), bfhi(uk.z), bflo(uk.w), bfhi(uk.w)};
            unsigned qo[4], ko[4];
#pragma unroll
            for (int q = 0; q < 4; ++q) {
                float c0 = cum[s * 64 + d0 + 2 * q], c1 = cum[s * 64 + d0 + 2 * q + 1];
                qo[q] = pk2(qv[2 * q] * 0.125f * __expf(c0), qv[2 * q + 1] * 0.125f * __expf(c1));
                ko[q] = pk2(kv[2 * q] * __expf(-c0), kv[2 * q + 1] * __expf(-c1));
            }
            *(v4u*)(QA + s * GS + d0) = (v4u){qo[0], qo[1], qo[2], qo[3]};
            *(v4u*)(KB + s * GS + d0) = (v4u){ko[0], ko[1], ko[2], ko[3]};
        }
        __syncthreads();
        f32x4 S[1][4];
#pragma unroll
        for (int n = 0; n < 4; ++n) S[0][n] = (f32x4){0.f, 0.f, 0.f, 0.f};
        wave_mma<1, 4>(QA + (w * 16) * GS, GS, KB, GS, 64, S);
#pragma unroll
        for (int n = 0; n < 4; ++n)
#pragma unroll
            for (int jj = 0; jj < 4; ++jj) {
                int t = w * 16 + fq * 4 + jj, s = n * 16 + fr;
                bool keep = dir ? (s >= t) : (s <= t);
                Pw[(fq * 4 + jj) * GS + s] = (bf16)f2bf(keep ? S[0][n][jj] : 0.f);
            }
        LDS_WAIT();
        __builtin_amdgcn_wave_barrier();
        wave_mma<1, 8>(Pw, GS, VTs, GS, 64, O);
        {
            const bf16* Sin = (const bf16*)(P.ws + OFF_Y) + (size_t)(chain * 132 + cp) * 8192;
#pragma unroll
            for (int ks = 0; ks < 2; ++ks) {
                bf16x8 a = *(const bf16x8*)(QA + (w * 16 + fr) * GS + ks * 32 + fq * 8);
#pragma unroll
                for (int n = 0; n < 8; ++n) {
                    bf16x8 bb = *(const bf16x8*)(Sin + (n * 16 + fr) * 64 + ks * 32 + fq * 8);
                    O[0][n] = __builtin_amdgcn_mfma_f32_16x16x32_bf16(a, bb, O[0][n], 0, 0, 0);
                }
            }
        }
        __syncthreads();
    }
    float ss[4];
#pragma unroll
    for (int jj = 0; jj < 4; ++jj) {
        float s = 0.f;
#pragma unroll
        for (int n = 0; n < 8; ++n) s += O[0][n][jj] * O[0][n][jj];
        s += __shfl_xor(s, 1); s += __shfl_xor(s, 2); s += __shfl_xor(s, 4); s += __shfl_xor(s, 8);
        ss[jj] = rsqrtf(s * (1.f / 128.f) + EPS);
    }
    bf16* YA = (bf16*)(P.ws + OFF_YA);
    const float* gn = P.gla_norm + l * 128;
#pragma unroll
    for (int n = 0; n < 8; ++n) {
        const int e = n * 16 + fr;
        const float gnv = gn[e];
#pragma unroll
        for (int jj = 0; jj < 4; ++jj) {
            int row = row0 + w * 16 + fq * 4 + jj;
            float gv = bf2f(Z[(size_t)row * NZ + 1024 + h * 128 + e]);
            YA[boff(row, h * 128 + e, 512)] = (bf16)f2bf(O[0][n][jj] * ss[jj] * gnv * siluf_(gv));
        }
    }
}

constexpr int KS_STRIDE = 104, VS_STRIDE = 72;
constexpr int ATT_BUF = 64 * KS_STRIDE * 2 + 64 * VS_STRIDE * 2;
DEVI void attn_item(const Params& P, int b, int h, int q0  , int k_lo, int k_hi, unsigned char* smem) {
    const int tid = ltid(), lane = tid & 63, w = tid >> 6, fr = lane & 15, fq = lane >> 4;
    const bf16* Q = (const bf16*)(P.ws + OFF_Q) + (size_t)(b * 8 + h) * NPOS * 96;
    const bf16* KF = (const bf16*)(P.ws + OFF_K) + (size_t)(b * 8 + h) * NPOS * 96;
    const bf16* VT = (const bf16*)(P.ws + OFF_VT) + (size_t)(b * 8 + h) * 64 * NPOS;
    bf16x8 Qf[2][3];
#pragma unroll
    for (int mi = 0; mi < 2; ++mi)
#pragma unroll
        for (int ks = 0; ks < 3; ++ks) Qf[mi][ks] = *(const bf16x8*)(Q + (size_t)(q0 + w * 32 + mi * 16 + fr) * 96 + ks * 32 + fq * 8);
    f32x4 O[2][4];
    float mrun[2], lrun[2];
#pragma unroll
    for (int mi = 0; mi < 2; ++mi) {
#pragma unroll
        for (int n = 0; n < 4; ++n) O[mi][n] = (f32x4){0.f, 0.f, 0.f, 0.f};
        mrun[mi] = 0.f; lrun[mi] = 0.f;
    }
    int kg[3], kl[3], vg[2], vl[2];
#pragma unroll
    for (int i = 0; i < 3; ++i) { int c = tid + NTHREADS * i; int key = c / 12, part = c - key * 12; kg[i] = key * 96 + part * 8; kl[i] = key * KS_STRIDE + part * 8; }
#pragma unroll
    for (int i = 0; i < 2; ++i) { int c = tid + NTHREADS * i; int dv = c >> 3, part = c & 7; vg[i] = dv * NPOS + part * 8; vl[i] = 64 * KS_STRIDE + dv * VS_STRIDE + part * 8; }
    v4u kr[3], vr[2];
#pragma unroll
    for (int i = 0; i < 3; ++i) kr[i] = *(const v4u*)(KF + (size_t)k_lo * 96 + kg[i]);
#pragma unroll
    for (int i = 0; i < 2; ++i) vr[i] = *(const v4u*)(VT + k_lo + vg[i]);
    __syncthreads();
    {
        bf16* B0 = (bf16*)smem;
#pragma unroll
        for (int i = 0; i < 3; ++i) *(v4u*)(B0 + kl[i]) = kr[i];
#pragma unroll
        for (int i = 0; i < 2; ++i) *(v4u*)(B0 + vl[i]) = vr[i];
    }
    __syncthreads();
    int cur = 0;
    for (int k0 = k_lo; k0 < k_hi; k0 += 64) {
        const bool more = (k0 + 64 < k_hi);
        const bf16* Ks = (const bf16*)(smem + cur * ATT_BUF);
        const bf16* Vs = Ks + 64 * KS_STRIDE;
        f32x4 S[2][4];
#pragma unroll
        for (int mi = 0; mi < 2; ++mi)
#pragma unroll
            for (int n = 0; n < 4; ++n) { const float nm = -mrun[mi]; S[mi][n] = (f32x4){nm, nm, nm, nm}; }
#pragma unroll
        for (int ks = 0; ks < 3; ++ks) {
            bf16x8 kf[4];
#pragma unroll
            for (int n = 0; n < 4; ++n) kf[n] = *(const bf16x8*)(Ks + (n * 16 + fr) * KS_STRIDE + ks * 32 + fq * 8);
#pragma unroll
            for (int mi = 0; mi < 2; ++mi)
#pragma unroll
                for (int n = 0; n < 4; ++n) S[mi][n] = __builtin_amdgcn_mfma_f32_16x16x32_bf16(kf[n], Qf[mi][ks], S[mi][n], 0, 0, 0);
        }
        if (more) {
#pragma unroll
            for (int i = 0; i < 3; ++i) kr[i] = *(const v4u*)(KF + (size_t)(k0 + 64) * 96 + kg[i]);
#pragma unroll
            for (int i = 0; i < 2; ++i) vr[i] = *(const v4u*)(VT + (k0 + 64) + vg[i]);
        }
        bf16x8 vf0[4], vf1[4];
#pragma unroll
        for (int n = 0; n < 4; ++n) {
            v2u lo = *(const v2u*)(Vs + (n * 16 + fr) * VS_STRIDE + fq * 4);
            v2u hi = *(const v2u*)(Vs + (n * 16 + fr) * VS_STRIDE + 16 + fq * 4);
            v4u vv = (v4u){lo.x, lo.y, hi.x, hi.y};
            vf0[n] = __builtin_bit_cast(bf16x8, vv);
        }
        const bool first = (k0 == k_lo);
        float mx[2];
#pragma unroll
        for (int mi = 0; mi < 2; ++mi) {
            float m0 = fmaxf(fmaxf(S[mi][0][0], S[mi][0][1]), fmaxf(S[mi][0][2], S[mi][0][3]));
#pragma unroll
            for (int n = 1; n < 4; ++n) m0 = fmaxf(m0, fmaxf(fmaxf(S[mi][n][0], S[mi][n][1]), fmaxf(S[mi][n][2], S[mi][n][3])));
            m0 = fmaxf(m0, __shfl_xor(m0, 16));
            m0 = fmaxf(m0, __shfl_xor(m0, 32));
            mx[mi] = m0;
        }
        if (__any(first || mx[0] > 8.f || mx[1] > 8.f)) {
#pragma unroll
            for (int mi = 0; mi < 2; ++mi) {
                const bool upd = first || mx[mi] > 8.f;
                const float dm = upd ? mx[mi] : 0.f;
                const float alpha = first ? 0.f : __builtin_amdgcn_exp2f(-dm);
                mrun[mi] += dm;
                lrun[mi] *= alpha;
#pragma unroll
                for (int n = 0; n < 4; ++n) {
                    O[mi][n][0] *= alpha; O[mi][n][1] *= alpha; O[mi][n][2] *= alpha; O[mi][n][3] *= alpha;
                    S[mi][n][0] -= dm; S[mi][n][1] -= dm; S[mi][n][2] -= dm; S[mi][n][3] -= dm;
                }
            }
        }
        float psum[2] = {0.f, 0.f};
#pragma unroll
        for (int s2 = 0; s2 < 2; ++s2) {
            bf16x8 Pb[2];
#pragma unroll
            for (int mi = 0; mi < 2; ++mi) {
#pragma unroll
                for (int n = 2 * s2; n < 2 * s2 + 2; ++n)
#pragma unroll
                    for (int jj = 0; jj < 4; ++jj) { float p = __builtin_amdgcn_exp2f(S[mi][n][jj]); S[mi][n][jj] = p; psum[mi] += p; }
                const v4u pk = pack8_for_mfma(S[mi][2 * s2][0], S[mi][2 * s2][1], S[mi][2 * s2][2], S[mi][2 * s2][3],
                                              S[mi][2 * s2 + 1][0], S[mi][2 * s2 + 1][1], S[mi][2 * s2 + 1][2], S[mi][2 * s2 + 1][3]);
                Pb[mi] = __builtin_bit_cast(bf16x8, pk);
            }
#pragma unroll
            for (int n = 0; n < 4; ++n) {
                const bf16x8 vf = (s2 == 0) ? vf0[n] : vf1[n];
#pragma unroll
                for (int mi = 0; mi < 2; ++mi) O[mi][n] = __builtin_amdgcn_mfma_f32_16x16x32_bf16(vf, Pb[mi], O[mi][n], 0, 0, 0);
            }
            if (s2 == 0) {
#pragma unroll
                for (int n = 0; n < 4; ++n) {
                    v2u lo = *(const v2u*)(Vs + (n * 16 + fr) * VS_STRIDE + 32 + fq * 4);
                    v2u hi = *(const v2u*)(Vs + (n * 16 + fr) * VS_STRIDE + 48 + fq * 4);
                    v4u vv = (v4u){lo.x, lo.y, hi.x, hi.y};
                    vf1[n] = __builtin_bit_cast(bf16x8, vv);
                }
            }
        }
        lrun[0] += psum[0]; lrun[1] += psum[1];
        if (more) {
            bf16* Bn = (bf16*)(smem + (cur ^ 1) * ATT_BUF);
#pragma unroll
            for (int i = 0; i < 3; ++i) *(v4u*)(Bn + kl[i]) = kr[i];
#pragma unroll
            for (int i = 0; i < 2; ++i) *(v4u*)(Bn + vl[i]) = vr[i];
        }
        __syncthreads();
        cur ^= 1;
    }
    bf16* YC = (bf16*)(P.ws + OFF_YC);
#pragma unroll
    for (int mi = 0; mi < 2; ++mi) {
        float l = lrun[mi];
        l += __shfl_xor(l, 16); l += __shfl_xor(l, 32);
        const float inv = 1.f / l;
        const int pos = q0 + w * 32 + mi * 16 + fr;
        const int row = row_of_pos(b, pos);
#pragma unroll
        for (int n = 0; n < 4; ++n) {
            v2u o; o.x = pk2(O[mi][n][0] * inv, O[mi][n][1] * inv); o.y = pk2(O[mi][n][2] * inv, O[mi][n][3] * inv);
            *(v2u*)(YC + boff(row, h * 64 + n * 16 + fq * 4, 512)) = o;
        }
    }
}

template <int MB>
DEVI void merge_tile(const Params& P, int row0, int col0, unsigned char* smem) {
    EPI_COORDS
    const bf16* H = (const bf16*)(P.ws + OFF_H);
    const bf16* WG = (const bf16*)(P.ws + OFF_WGATE);
    const bf16* WB = (const bf16*)(P.ws + OFF_WBR);
    bf16* M1 = (bf16*)(P.ws + OFF_BIG);
    f32x4 tot[MB][4]; zero_acc<MB>(tot);
    for (int i = 0; i < 3; ++i) {
        f32x4 acc[MB][4]; zero_acc<MB>(acc);
        gemm_ml<MB, 3>(H, D, WG + (size_t)i * D * D, D, D, row0, col0, smem, acc);
        unsigned gpr[2][4][2];
        unsigned* gpl = (unsigned*)(smem + 49152) + tid;
#pragma unroll
        for (int m = 0; m < MB; ++m)
#pragma unroll
            for (int n = 0; n < 4; ++n) {
                const unsigned g0 = pk2(sigmoidf_(acc[m][n][0]), sigmoidf_(acc[m][n][1]));
                const unsigned g1 = pk2(sigmoidf_(acc[m][n][2]), sigmoidf_(acc[m][n][3]));
                if (m < 2) { gpr[m][n][0] = g0; gpr[m][n][1] = g1; }
                else { gpl[((m - 2) * 8 + n * 2 + 0) * NTHREADS] = g0; gpl[((m - 2) * 8 + n * 2 + 1) * NTHREADS] = g1; }
            }
        zero_acc<MB>(acc);
        const bf16* Yi = (const bf16*)(P.ws + (i == 0 ? OFF_YA : i == 1 ? OFF_YB : OFF_YC));
        gemm_ml<MB, 3>(Yi, 512, WB + (size_t)i * D * 512, 512, 512, row0, col0, smem, acc);
#pragma unroll
        for (int m = 0; m < MB; ++m)
#pragma unroll
            for (int n = 0; n < 4; ++n) {
                unsigned g0, g1;
                if (m < 2) { g0 = gpr[m][n][0]; g1 = gpr[m][n][1]; }
                else { g0 = gpl[((m - 2) * 8 + n * 2 + 0) * NTHREADS]; g1 = gpl[((m - 2) * 8 + n * 2 + 1) * NTHREADS]; }
                tot[m][n][0] += bflo(g0) * acc[m][n][0]; tot[m][n][1] += bfhi(g0) * acc[m][n][1];
                tot[m][n][2] += bflo(g1) * acc[m][n][2]; tot[m][n][3] += bfhi(g1) * acc[m][n][3];
            }
    }
#pragma unroll
    for (int m = 0; m < MB; ++m)
#pragma unroll
        for (int n = 0; n < 4; ++n)
#pragma unroll
            for (int jj = 0; jj < 4; ++jj) {
                int row = row0 + wr * (MB * 16) + m * 16 + fq * 4 + jj;
                int col = col0 + wc * 64 + n * 16 + fr;
                M1[boff(row, col, D)] = (bf16)f2bf(tot[m][n][jj]);
            }
}
DEVI void merge_phase(const Params& P, bool with_ctx, unsigned char* smem) {
    const int nbig = (ML / 128) * 8, total = nbig + (with_ctx ? (MC / 64) * 8 : 0);
    FOR_ITEMS(L, total) {
        if (L < nbig) { int tm, tn; tile_map(L, ML / 128, 8, tm, tn); merge_tile<4>(P, tm * 128, tn * 128, smem); }
        else { int r = L - nbig; merge_tile<2>(P, ML + (r >> 3) * 64, (r & 7) * 128, smem); }
    }
}

#define XB_TMO      128
#define XB_XCNT(j)  (256  + 64 * (j))
#define XB_XSUB(j)  (1280 + 64 * (j))
#define XB_XGEN(j)  (2304 + 64 * (j))
#define XB_TOP      3328
#define XB_TOPGEN   3392
#define XCD_BAR_WORDS 3456
#define XB_SPIN_CAP (1u << 18)
DEVI unsigned xb_ld(unsigned* p)              { return __hip_atomic_load(p, __ATOMIC_RELAXED, __HIP_MEMORY_SCOPE_AGENT); }
DEVI unsigned xb_add(unsigned* p, unsigned v) { return __hip_atomic_fetch_add(p, v, __ATOMIC_RELAXED, __HIP_MEMORY_SCOPE_AGENT); }
DEVI unsigned xb_xcc_id() { return (unsigned)__builtin_amdgcn_s_getreg((3 << 11) | 20) & 0xFu; }
#define XB_SPIN(cond, bar) do { unsigned _sp = 0; while (cond) { __builtin_amdgcn_s_sleep(1); \
    if ((++_sp & 255u) == 0u) { if (xb_ld(&(bar)[XB_TMO])) break; if (_sp > XB_SPIN_CAP) { atomicAdd(&(bar)[XB_TMO], 1u); break; } } } } while (0)
struct XcdBarrier { unsigned* bar; unsigned x; volatile LAS unsigned* st; };
DEVI XcdBarrier xcd_barrier_post(unsigned* bar, volatile LAS unsigned* st) {
    XcdBarrier b; b.bar = bar; b.x = xb_xcc_id(); b.st = st;
    if (threadIdx.x == 0) (void)xb_add(&bar[XB_XCNT(b.x)], 1u);
    return b;
}
DEVI void xcd_barrier_complete(unsigned* bar, unsigned x, unsigned& nloc, unsigned& nx) {
    const unsigned G = gridDim.x * gridDim.y * gridDim.z;
    unsigned sum, cnt, mine, sp = 0u;
    for (;;) {
        sum = 0u; cnt = 0u; mine = 0u;
#pragma unroll
        for (unsigned j = 0; j < 16; ++j) { const unsigned c = xb_ld(&bar[XB_XCNT(j)]); sum += c; cnt += (c > 0u) ? 1u : 0u; mine = (j == x) ? c : mine; }
        if (sum == G) break;
        __builtin_amdgcn_s_sleep(1);
        if ((++sp & 255u) == 0u) { if (xb_ld(&bar[XB_TMO])) break; if (sp > XB_SPIN_CAP) { atomicAdd(&bar[XB_TMO], 1u); break; } }
    }
    nloc = mine > 0u ? mine : 1u; nx = cnt > 0u ? cnt : 1u;
}
DEVI void xcd_barrier(const XcdBarrier& b) {
    asm volatile("s_waitcnt vmcnt(0)" ::: "memory");
    __syncthreads();
    if (threadIdx.x == 0) {
        unsigned* bar = b.bar;
        __builtin_amdgcn_s_waitcnt(0);
        unsigned nloc = b.st[0], nx = b.st[1];
        if (nloc == 0u) { xcd_barrier_complete(bar, b.x, nloc, nx); b.st[0] = nloc; b.st[1] = nx; }
        const unsigned old = xb_add(&bar[XB_XSUB(b.x)], 1u);
        const unsigned gen = old / nloc;
        if (old + 1u == (gen + 1u) * nloc) {
            __builtin_amdgcn_fence(__ATOMIC_RELEASE, "agent");
            asm volatile("s_waitcnt vmcnt(0)" ::: "memory");
            const unsigned og = xb_add(&bar[XB_TOP], 1u);
            const unsigned tg = og / nx;
            if (og + 1u == (tg + 1u) * nx) xb_add(&bar[XB_TOPGEN], 1u);
            else XB_SPIN(xb_ld(&bar[XB_TOPGEN]) == tg, bar);
            __builtin_amdgcn_fence(__ATOMIC_ACQUIRE, "agent");
            xb_add(&bar[XB_XGEN(b.x)], 1u);
            asm volatile("s_waitcnt vmcnt(0)" ::: "memory");
        } else {
            XB_SPIN(xb_ld(&bar[XB_XGEN(b.x)]) == gen, bar);
            __builtin_amdgcn_fence(__ATOMIC_ACQUIRE, "agent");
            asm volatile("s_waitcnt vmcnt(0)" ::: "memory");
        }
    }
    __syncthreads();
}

__global__ void __launch_bounds__(NTHREADS, 2) mega(Params P0) {
    extern __shared__ __attribute__((aligned(16))) unsigned char smem[];
    volatile LAS unsigned* bst = (volatile LAS unsigned*)(smem + LDS_MAIN);
    if (threadIdx.x < 2) bst[threadIdx.x] = 0u;
    __syncthreads();
    XcdBarrier xbar; xbar.bar = (unsigned*)(P0.ws + OFF_BAR); xbar.x = 0; xbar.st = bst;
    if (P0.coop == 1) xbar = xcd_barrier_post((unsigned*)(P0.ws + OFF_BAR), bst);
    for (int ph = P0.ph_lo; ph < P0.ph_hi; ++ph) {
        Params P = P0;
        {
            size_t z = 0;
            asm volatile("" : "+s"(z));
            const float** pp = (const float**)&P;
#pragma unroll
            for (int i = 0; i < 21; ++i) pp[i] = pp[i] + z;
            P.out = P.out + z; P.ws = P.ws + z;
        }
        unsigned char* ws = P.ws;
        const float* MOD = (const float*)(ws + OFF_MOD);
#if DUP_MASK
        const int nrep = (ph >= 2 && ((DUP_MASK >> ((ph - 2) % 15)) & 1)) ? 2 : 1;
        for (int rep = 0; rep < nrep; ++rep) {
        if (rep) xcd_barrier(xbar);
#endif
        if (ph == 0) {
            prep_phase(P, 0, true, smem);
        } else if (ph == 1) {
            norm_phase(P, MT, true, false, 0.f, nullptr, nullptr, 0, true, P.norm_pre + 0 * D, MOD, 0);
        } else {
            const int l = (ph - 2) / 15, s = (ph - 2) % 15;
            const bool last = (l == 1);
            const float* modl = MOD + (size_t)l * 3 * NMOD;
            const int mrows = last ? ML : MT;
            switch (s) {
            case 0: gemm_gu_phase(P, 0, MT / 256, smem); break;
            case 1: gemm_plain_phase((const bf16*)(ws + OFF_BIG), DFF, (const bf16*)(ws + OFF_WD), DFF, (bf16*)(ws + OFF_Y), D, ML, MC, smem); break;
            case 2: norm_phase(P, MT, l == 0, true, 0.5f, P.norm_post + (l * 3 + 0) * D, modl, 2, true, P.norm_pre + (l * 3 + 1) * D, modl, 3); break;
            case 3: gemm_win_phase(P, smem); break;
            case 4: {
                const int n_fft = last ? 1024 : 2048, n_q = 132 * 6, n_kv = 132 * 8;
                const int total = n_fft + n_q + n_kv;
                const float* TW = (const float*)(ws + OFF_TW);
                const bf16* PT = (const bf16*)(ws + OFF_Y);
                FOR_ITEMS(it, total) {
                    int r = it;
                    if (r < n_fft) {
                        const int isc = r >> 10, cc = r & 1023, b = cc >> 9, c = cc & 511;
                        const bf16* re = PT + ((size_t)(b * 1024 + c)) * NPOS + (isc ? SEQ : 0);
                        const bf16* im = re + (size_t)512 * NPOS;
                        if (!isc) fft_item(re, im, SEQ, (bf16*)re, 1, 9.765625e-4f  , TW, smem);
                        else fft_item(re, im, CTXL, (bf16*)re, 1, 5.524271728019903e-3f  , TW, smem);
                        continue;
                    }
                    r -= n_fft;
                    if (r < n_q) { mla_q_tile(P, r / 6, r % 6, smem); continue; }
                    r -= n_q;
                    mla_kv_tile(P, r >> 3, r & 7, smem);
                }
            } break;
            case 5: {
                const int n_tr = last ? 2048 : 2112, n_al = 2 * 8 * 64, n_ac = last ? 0 : 2 * 8 * 2;
                const int total = n_tr + n_al + n_ac;
                FOR_ITEMS(it, total) {
                    int r = it;
                    if (r < n_tr) { ybt_transpose_item(P, r, smem); continue; }
                    r -= n_tr;
                    if (r < n_al) { attn_item(P, r >> 9, (r >> 6) & 7, (r & 63) * 128, 0, NPOS, smem); continue; }
                    r -= n_al;
                    attn_item(P, r >> 4, (r >> 1) & 7, SEQ + (r & 1) * 128, SEQ, NPOS, smem);
                }
            } break;
            case 6:
                FOR_ITEMS(it, 16 * 132) gla_local_item(P, l, it, smem);
                break;
            case 7: gla_scan_phase(P); break;
            case 8:
                FOR_ITEMS(it, 8 * 132) gla_out_item(P, l, it, last, smem);
                break;
            case 9: merge_phase(P, !last, smem); break;
            case 10: gemm_plain_phase((const bf16*)(ws + OFF_BIG), D, (const bf16*)(ws + OFF_WOUT), D, (bf16*)(ws + OFF_Y), D, ML, last ? 0 : MC, smem); break;
            case 11: norm_phase(P, mrows, false, true, 1.0f, P.norm_post + (l * 3 + 1) * D, modl, 5, true, P.norm_pre + (l * 3 + 2) * D, modl, 6); break;
            case 12: gemm_gu_phase(P, 1, mrows / 256, smem); break;
            case 13: gemm_plain_phase((const bf16*)(ws + OFF_BIG), DFF, (const bf16*)(ws + OFF_WD) + (size_t)D * DFF, DFF, (bf16*)(ws + OFF_Y), D, ML, last ? 0 : MC, smem); break;
            case 14:
                norm_phase(P, mrows, false, true, 0.5f, P.norm_post + (l * 3 + 2) * D, modl, 8, !last, P.norm_pre + ((l + 1) * 3 + 0) * D, MOD + (size_t)(l + 1) * 3 * NMOD, 0);
                if (!last) prep_phase(P, 1, false, smem);
                break;
            }
        }
#if DUP_MASK
        }
#endif
        if (ph + 1 < P0.ph_hi) { if (P0.coop == 1) xcd_barrier(xbar); else if (P0.coop == 2) cg::this_grid().sync(); }
    }
}

extern "C" void kernel_launch(void* const* d_in, const int* in_sizes, int n_in, void* d_out, int out_size, void* d_ws, size_t ws_size, hipStream_t stream) {
    static int grid = 0;
    if (grid == 0) {
        if (n_in != 21 || out_size != ML * D || ws_size < WS_END) { fprintf(stderr, "kernel_launch: unexpected shapes/workspace (n_in %d out %d ws %zu need %zu)\n", n_in, out_size, ws_size, (size_t)WS_END); grid = -1; return; }
        int dev = 0, cus = 0, per_cu = 0;
        hipGetDevice(&dev);
        hipDeviceGetAttribute(&cus, hipDeviceAttributeMultiprocessorCount, dev);
        hipFuncSetAttribute((const void*)mega, hipFuncAttributeMaxDynamicSharedMemorySize, LDS_BYTES);
        hipOccupancyMaxActiveBlocksPerMultiprocessor(&per_cu, (const void*)mega, NTHREADS, LDS_BYTES);
        if (per_cu < 1) per_cu = 1;
        if (per_cu > 2) per_cu = 2;
        grid = cus * per_cu;
        (void)hipGetLastError();
    }
    if (grid < 0) return;
    Params p{};
    const float** pp = (const float**)&p;
    for (int i = 0; i < 21; ++i) pp[i] = (const float*)d_in[i];
    p.out = (float*)d_out; p.ws = (unsigned char*)d_ws;
#if MK_PER_PHASE
    for (int ph = 0; ph < NPHASES; ++ph) {
        p.ph_lo = ph; p.ph_hi = ph + 1; p.coop = 0;
        hipLaunchKernelGGL(mega, dim3(grid), dim3(NTHREADS), LDS_BYTES, stream, p);
    }
#else
    p.ph_lo = 0; p.ph_hi = NPHASES; p.coop = 1;
    (void)hipMemsetAsync(d_ws, 0, BAR_BYTES, stream);
    void* args[] = {&p};
    hipError_t e = hipLaunchCooperativeKernel((const void*)mega, dim3(grid), dim3(NTHREADS), args, LDS_BYTES, stream);
    if (e != hipSuccess) fprintf(stderr, "cooperative launch failed: %s (grid %d)\n", hipGetErrorString(e), grid);
#endif
}
```

```cpp
#include <hip/hip_runtime.h>
#include <hip/hip_cooperative_groups.h>
#include <stdint.h>
#include <cstdio>
namespace cg = cooperative_groups;

#ifndef DUP_MASK
#define DUP_MASK 0
#endif
#ifndef MK_PER_PHASE
#define MK_PER_PHASE 0
#endif

typedef unsigned short bf16;
typedef short bf16x8 __attribute__((ext_vector_type(8)));
typedef float f32x4 __attribute__((ext_vector_type(4)));
typedef unsigned v4u __attribute__((ext_vector_type(4)));
typedef unsigned v2u __attribute__((ext_vector_type(2)));
#define DEVI __device__ __forceinline__
#define GAS __attribute__((address_space(1)))
#define LAS __attribute__((address_space(3)))

constexpr int D = 1024, NB = 2, SEQ = 8192, CTXL = 256, ML = NB * SEQ, MC = NB * CTXL, MT = ML + MC;
constexpr int DFF = 2816, NGU = 2 * DFF, DIN = 5824, NZ = 2304, NWIN = 3328, NPOS = SEQ + CTXL;
constexpr int NMOD = 9 * D;
constexpr float EPS = 1e-6f;
constexpr int NTHREADS = 256;
constexpr int LDS_MAIN = 73728;
constexpr int LDS_BYTES = LDS_MAIN + 64;
constexpr int NPHASES = 32;

constexpr size_t al(size_t x) { return (x + 255) & ~(size_t)255; }
constexpr size_t OFF_BAR = 0;
constexpr size_t BAR_BYTES = 16384;
constexpr size_t OFF_MOD = BAR_BYTES;
constexpr size_t OFF_ROPE = al(OFF_MOD + (size_t)2 * 3 * NMOD * 4);
constexpr size_t OFF_TW = al(OFF_ROPE + 128 * 8 * 2 * 4);
constexpr size_t OFF_DEC = al(OFF_TW + 4096 * 2 * 4);
constexpr size_t OFF_XC = al(OFF_DEC + 16 * 132 * 64 * 4);
constexpr size_t OFF_WGU = al(OFF_XC + (size_t)MC * D * 4);
constexpr size_t OFF_WD = al(OFF_WGU + (size_t)2 * NGU * D * 2);
constexpr size_t OFF_WIN = al(OFF_WD + (size_t)2 * D * DFF * 2);
constexpr size_t OFF_WGATE = al(OFF_WIN + (size_t)NWIN * D * 2);
constexpr size_t OFF_WBR = al(OFF_WGATE + (size_t)3072 * D * 2);
constexpr size_t OFF_WOUT = al(OFF_WBR + (size_t)3 * D * 512 * 2);
constexpr size_t OFF_WUQ = al(OFF_WOUT + (size_t)D * D * 2);
constexpr size_t OFF_WUKV = al(OFF_WUQ + (size_t)768 * 384 * 2);
constexpr size_t OFF_H = al(OFF_WUKV + (size_t)1024 * 256 * 2);
constexpr size_t OFF_BIG = al(OFF_H + (size_t)MT * D * 2);
constexpr size_t OFF_YC = OFF_BIG + (size_t)MT * NZ * 2;
constexpr size_t OFF_Y = al(OFF_BIG + (size_t)MT * DFF * 2);
constexpr size_t OFF_YA = al(OFF_Y + (size_t)MT * D * 2);
constexpr size_t OFF_YB = al(OFF_YA + (size_t)MT * 512 * 2);
constexpr size_t OFF_Q = al(OFF_YB + (size_t)MT * 512 * 2);
constexpr size_t OFF_K = al(OFF_Q + (size_t)16 * NPOS * 96 * 2);
constexpr size_t OFF_VT = al(OFF_K + (size_t)16 * NPOS * 96 * 2);
constexpr size_t OFF_GVT = al(OFF_VT + (size_t)16 * 64 * NPOS * 2);
constexpr size_t WS_END = al(OFF_GVT + (size_t)8 * 128 * NPOS * 2);
static_assert((size_t)MT * NZ * 2 + (size_t)MT * 512 * 2 == (size_t)MT * DFF * 2, "YC fits the ACT tail");
static_assert((size_t)2 * 1024 * NPOS * 2 == (size_t)MT * D * 2 && (size_t)16 * 132 * 8192 * 2 == (size_t)MT * D * 2, "PT/ST alias Y");

struct Params {
    const float *x, *c, *ctx, *c_ctx, *w_mod, *b_mod, *norm_pre, *norm_post, *wg, *wu, *wd, *w_in, *gla_wdec, *gla_bdec, *gla_norm,
        *q_norm, *w_uq, *kv_norm, *w_ukv, *w_branch, *w_out;
    float* out;
    unsigned char* ws;
    int ph_lo, ph_hi, coop, pad;
};

DEVI int ltid() { int t = threadIdx.x; asm volatile("" : "+v"(t)); return t; }
DEVI int lbid() { int t = blockIdx.x; asm volatile("" : "+s"(t)); return t; }
DEVI unsigned f2bf(float f) { unsigned u = __float_as_uint(f); return (u + 0x7fffu + ((u >> 16) & 1u)) >> 16; }
DEVI float bf2f(unsigned h) { return __uint_as_float(h << 16); }
DEVI unsigned pk2(float lo, float hi) { unsigned r; asm("v_cvt_pk_bf16_f32 %0, %1, %2" : "=v"(r) : "v"(lo), "v"(hi)); return r; }
DEVI float bflo(unsigned u) { return __uint_as_float(u << 16); }
DEVI float bfhi(unsigned u) { return __uint_as_float(u & 0xffff0000u); }
DEVI float sigmoidf_(float x) { return 1.f / (1.f + __expf(-x)); }
DEVI float siluf_(float x) { return x / (1.f + __expf(-x)); }
DEVI float logsigmoidf_(float x) { return fminf(x, 0.f) - __logf(1.f + __expf(-fabsf(x))); }
DEVI v4u pack8_for_mfma(float a0, float a1, float a2, float a3, float a4, float a5, float a6, float a7) {
    unsigned r0, r1, r2, r3;
    asm("v_cvt_pk_bf16_f32 %0, %4, %5\n\tv_cvt_pk_bf16_f32 %1, %6, %7\n\tv_cvt_pk_bf16_f32 %2, %8, %9\n\tv_cvt_pk_bf16_f32 %3, %10, %11\n\ts_nop 1"
        : "=&v"(r0), "=&v"(r1), "=&v"(r2), "=&v"(r3)
        : "v"(a0), "v"(a1), "v"(a2), "v"(a3), "v"(a4), "v"(a5), "v"(a6), "v"(a7));
    return (v4u){r0, r1, r2, r3};
}
#define LDS_WAIT() asm volatile("s_waitcnt lgkmcnt(0)" ::: "memory")
#define VM_WAIT() asm volatile("s_waitcnt vmcnt(0)" ::: "memory")

DEVI void dsincos(double x, double& s, double& c) {
    const double hp = 1.5707963267948966192313216916398;
    double kd = rint(x / hp);
    double r = x - kd * hp;
    int k = ((int)kd) & 3;
    double r2 = r * r;
    double sn = r * (1.0 + r2 * (-1.0 / 6 + r2 * (1.0 / 120 + r2 * (-1.0 / 5040 + r2 * (1.0 / 362880 + r2 * (-1.0 / 39916800 + r2 * (1.0 / 6227020800.0)))))));
    double cs = 1.0 + r2 * (-0.5 + r2 * (1.0 / 24 + r2 * (-1.0 / 720 + r2 * (1.0 / 40320 + r2 * (-1.0 / 3628800 + r2 * (1.0 / 479001600.0 + r2 * (-1.0 / 87178291200.0)))))));
    if (k == 0) { s = sn; c = cs; } else if (k == 1) { s = cs; c = -sn; } else if (k == 2) { s = -sn; c = -cs; } else { s = -cs; c = sn; }
}

DEVI size_t boff(int row, int k, int K) { return ((size_t)(row >> 4) * (K >> 5) + (k >> 5)) * 512 + (row & 15) * 32 + (k & 31); }
DEVI int row_of_pos(int b, int pos) { return pos < SEQ ? b * SEQ + pos : ML + b * CTXL + (pos - SEQ); }

template <int MB, int NS, bool SWAP = false, bool BLK = true>
DEVI void gemm_ml(const bf16* __restrict__ A, int lda, const bf16* __restrict__ Bt, int ldb, int K, int row0, int col0,
                  unsigned char* smem, f32x4 (&acc)[MB][4]) {
    const int tid = ltid(), lane = tid & 63, wid = tid >> 6, wr = wid >> 1, wc = wid & 1, fr = lane & 15, fq = lane >> 4;
    constexpr int AROWS = 32 * MB, ABYTES = AROWS * 64, STG = ABYTES + 8192, NA = AROWS / 64, NL = NA + 2;
    const int r_ = tid >> 2, c_ = (tid & 3) * 8;
    const bf16* ap = BLK ? A + (size_t)((row0 >> 4) + (r_ >> 4)) * (lda >> 5) * 512 + (r_ & 15) * 32 + c_ : A + (size_t)(row0 + r_) * lda + c_;
    const bf16* bp = BLK ? Bt + (size_t)((col0 >> 4) + (r_ >> 4)) * (ldb >> 5) * 512 + (r_ & 15) * 32 + c_ : Bt + (size_t)(col0 + r_) * ldb + c_;
    const size_t a64 = BLK ? (size_t)4 * (lda >> 5) * 512 : (size_t)64 * lda;
    const size_t b64 = BLK ? (size_t)4 * (ldb >> 5) * 512 : (size_t)64 * ldb;
#define GSTAGE(buf, kk) do { unsigned char* sa_ = smem + (buf) * STG; const size_t ko_ = BLK ? (size_t)(kk) * 16 : (size_t)(kk); \
    _Pragma("unroll") for (int i_ = 0; i_ < NA; ++i_) __builtin_amdgcn_global_load_lds((const GAS unsigned*)(ap + i_ * a64 + ko_), (LAS unsigned*)(sa_ + tid * 16 + i_ * 4096), 16, 0, 0); \
    _Pragma("unroll") for (int i_ = 0; i_ < 2; ++i_) __builtin_amdgcn_global_load_lds((const GAS unsigned*)(bp + i_ * b64 + ko_), (LAS unsigned*)(sa_ + ABYTES + tid * 16 + i_ * 4096), 16, 0, 0); } while (0)
    const int nk = K >> 5;
    __syncthreads();
#pragma unroll
    for (int s0 = 0; s0 < NS - 1; ++s0) if (s0 < nk) GSTAGE(s0, s0 * 32);
    int buf = 0;
    for (int it = 0; it < nk; ++it) {
        if (NS >= 3 && it + 1 < nk) asm volatile("s_waitcnt vmcnt(%0)" ::"n"(NL) : "memory");
        else asm volatile("s_waitcnt vmcnt(0)" ::: "memory");
        asm volatile("" ::: "memory");
        __builtin_amdgcn_s_barrier();
        asm volatile("" ::: "memory");
        if (it + NS - 1 < nk) { int nb = buf + NS - 1; if (nb >= NS) nb -= NS; GSTAGE(nb, (it + NS - 1) * 32); }
        const unsigned char* SA = smem + buf * STG;
        const unsigned char* SB = SA + ABYTES;
        bf16x8 Bf[4], Af[MB];
#pragma unroll
        for (int n = 0; n < 4; ++n) Bf[n] = *(const bf16x8*)(SB + (wc * 64 + n * 16 + fr) * 64 + fq * 16);
#pragma unroll
        for (int m = 0; m < MB; ++m) Af[m] = *(const bf16x8*)(SA + (wr * (MB * 16) + m * 16 + fr) * 64 + fq * 16);
        __builtin_amdgcn_sched_barrier(0);
#pragma unroll
        for (int m = 0; m < MB; ++m)
#pragma unroll
            for (int n = 0; n < 4; ++n) {
                if (SWAP) acc[m][n] = __builtin_amdgcn_mfma_f32_16x16x32_bf16(Bf[n], Af[m], acc[m][n], 0, 0, 0);
                else acc[m][n] = __builtin_amdgcn_mfma_f32_16x16x32_bf16(Af[m], Bf[n], acc[m][n], 0, 0, 0);
            }
        __builtin_amdgcn_sched_barrier(0);
        buf = (buf == NS - 1) ? 0 : buf + 1;
    }
#undef GSTAGE
}
template <int MB>
DEVI void zero_acc(f32x4 (&acc)[MB][4]) {
#pragma unroll
    for (int m = 0; m < MB; ++m)
#pragma unroll
        for (int n = 0; n < 4; ++n) acc[m][n] = (f32x4){0.f, 0.f, 0.f, 0.f};
}
DEVI int xcd_slot() { const int G = gridDim.x, b = lbid(); return (G & 7) ? b : (b & 7) * (G >> 3) + (b >> 3); }
#define FOR_ITEMS(L, total) for (int L##_r = 0, L##_s = xcd_slot(), L; L##_r < (total); L##_r += gridDim.x) if ((L = L##_r + L##_s) < (total))
DEVI void tile_map(int L, int MTILES, int NT, int& tm, int& tn) {
    const int PH = (MTILES % 8 == 0) ? 8 : (MTILES % 6 == 0) ? 6 : 4;
    int p = L / (PH * NT), w = L - p * PH * NT;
    tn = w / PH; tm = p * PH + (w - tn * PH);
}

DEVI void transpose_item(const float* __restrict__ W, int ldsrc, int k0, int n0, const float* __restrict__ kscale, bf16* __restrict__ WT, int ldk,
                         int R0, float* scr, int lane, bool blk = true) {
    {
        const int kq = lane >> 3, n4 = (lane & 7) * 4;
        f32x4 v[8];
#pragma unroll
        for (int i = 0; i < 8; ++i) v[i] = *(const f32x4*)(W + (size_t)(k0 + i * 8 + kq) * ldsrc + n0 + n4);
#pragma unroll
        for (int i = 0; i < 8; ++i) {
            const int kk = i * 8 + kq;
            const float sc = kscale ? kscale[k0 + kk] : 1.f;
            float* d = scr + kk * 33 + n4;
            d[0] = v[i].x * sc; d[1] = v[i].y * sc; d[2] = v[i].z * sc; d[3] = v[i].w * sc;
        }
    }
    LDS_WAIT();
    __builtin_amdgcn_wave_barrier();
    const int c = lane & 7;
#pragma unroll
    for (int j = 0; j < 4; ++j) {
        const int n = (lane >> 3) + 8 * j;
        const float* s = scr + (8 * c) * 33 + n;
        v4u o;
        o.x = pk2(s[0], s[33]); o.y = pk2(s[66], s[99]); o.z = pk2(s[132], s[165]); o.w = pk2(s[198], s[231]);
        *(v4u*)(WT + (blk ? boff(R0 + n, k0 + 8 * c, ldk) : (size_t)(R0 + n) * ldk + k0 + 8 * c)) = o;
    }
    LDS_WAIT();
    __builtin_amdgcn_wave_barrier();
}

DEVI void transpose_dispatch(const Params& P, int l, int it, float* scr, int lane) {
    unsigned char* ws = P.ws;
    int r = it;
    if (r < 4 * 1408) {
        int jh = r / 1408; r -= jh * 1408;
        int j = jh >> 1, half = jh & 1;
        int kb = r / 88, nb = r - kb * 88, n0 = nb * 32;
        const float* src = (half ? P.wu : P.wg) + (size_t)(l * 2 + j) * D * DFF;
        int R0 = (n0 >> 6) * 128 + ((n0 >> 5) & 1) * 64 + half * 32;
        transpose_item(src, DFF, kb * 64, n0, nullptr, (bf16*)(ws + OFF_WGU) + (size_t)j * NGU * D, D, R0, scr, lane);
        return;
    }
    r -= 4 * 1408;
    if (r < 2 * 1408) {
        int j = r / 1408; r -= j * 1408;
        int kb = r >> 5, nb = r & 31;
        transpose_item(P.wd + (size_t)(l * 2 + j) * DFF * D, D, kb * 64, nb * 32, nullptr, (bf16*)(ws + OFF_WD) + (size_t)j * D * DFF, DFF, nb * 32, scr, lane);
        return;
    }
    r -= 2 * 1408;
    if (r < 2912) {
        int kb = r / 182, nb = r - kb * 182, n0 = nb * 32;
        bf16* dst = (bf16*)(ws + OFF_WIN);
        int R0;
        if (n0 < 1536) R0 = n0;
        else if (n0 < 1568) R0 = 2176;
        else if (n0 < 2080) return;
        else if (n0 < 2464) R0 = 1536 + (n0 - 2080);
        else if (n0 < 2720) R0 = 1920 + (n0 - 2464);
        else if (n0 < 2752) R0 = 2208;
        else { dst = (bf16*)(ws + OFF_WGATE); R0 = n0 - 2752; }
        transpose_item(P.w_in + (size_t)l * D * DIN, DIN, kb * 64, n0, nullptr, dst, D, R0, scr, lane);
        return;
    }
    r -= 2912;
    if (r < 768) {
        int i = r >> 8; r &= 255;
        int kb = r >> 5, nb = r & 31;
        transpose_item(P.w_branch + (size_t)(l * 3 + i) * 512 * D, D, kb * 64, nb * 32, nullptr, (bf16*)(ws + OFF_WBR) + (size_t)i * D * 512, 512, nb * 32, scr, lane);
        return;
    }
    r -= 768;
    if (r < 512) {
        int kb = r >> 5, nb = r & 31;
        transpose_item(P.w_out + (size_t)l * D * D, D, kb * 64, nb * 32, nullptr, (bf16*)(ws + OFF_WOUT), D, nb * 32, scr, lane);
        return;
    }
    r -= 512;
    if (r < 144) {
        int kb = r / 24, nb = r - kb * 24;
        transpose_item(P.w_uq + (size_t)l * 384 * 768, 768, kb * 64, nb * 32, P.q_norm + l * 384, (bf16*)(ws + OFF_WUQ), 384, nb * 32, scr, lane, false);
        return;
    }
    r -= 144;
    {
        int kb = r >> 5, nb = r & 31;
        transpose_item(P.w_ukv + (size_t)l * 256 * 1024, 1024, kb * 64, nb * 32, P.kv_norm + l * 256, (bf16*)(ws + OFF_WUKV), 256, nb * 32, scr, lane, false);
    }
}
constexpr int N_TR_WAVE_ITEMS = 6 * 1408 + 2912 + 768 + 512 + 144 + 128;
constexpr int N_TR_BLOCK_ITEMS = N_TR_WAVE_ITEMS / 4;
static_assert(N_TR_WAVE_ITEMS % 4 == 0, "");

DEVI void fold_item(const Params& P, int l, int it, unsigned char* smem) {
    const int tid = ltid();
    const int g = it >> 4, k0 = (it & 15) * 64;
    float* Wt = (float*)smem;
    float* ct = Wt + 64 * 128;
    __syncthreads();
    const float* src = P.w_in + (size_t)l * D * DIN + 1568 + g * 128;
    for (int idx = tid; idx < 64 * 128; idx += NTHREADS) { int kk = idx >> 7, cc = idx & 127; Wt[idx] = src[(size_t)(k0 + kk) * DIN + cc]; }
    if (tid < 128) { double s, c; dsincos(6.283185307179586476925286766559 * (double)tid / 128.0, s, c); ct[tid] = (float)c; ct[128 + tid] = (float)s; }
    __syncthreads();
    const int k2 = tid & 127, part = tid >> 7;
    bf16* dst = (bf16*)(P.ws + OFF_WIN) + boff(2304 + part * 512 + g * 128 + k2, k0, D);
    for (int kk = 0; kk < 64; kk += 8) {
        float a[8];
#pragma unroll
        for (int u = 0; u < 8; ++u) a[u] = 0.f;
        for (int c = 0; c < 128; ++c) {
            int m = (c * k2) & 127;
            float tw = part ? -ct[128 + m] : ct[m];
#pragma unroll
            for (int u = 0; u < 8; ++u) a[u] += Wt[(kk + u) * 128 + c] * tw;
        }
        v4u o; o.x = pk2(a[0], a[1]); o.y = pk2(a[2], a[3]); o.z = pk2(a[4], a[5]); o.w = pk2(a[6], a[7]);
        *(v4u*)(dst + (kk >> 5) * 512 + (kk & 31)) = o;
    }
}

DEVI void mod_item(const Params& P, int it, unsigned char* smem) {
    const int tid = ltid(), lane = tid & 63, w = tid >> 6;
    const int l = it / 144, n0 = (it - l * 144) * 64;
    float* sc = (float*)smem;
    float* red = sc + 3 * 1024;
    __syncthreads();
    for (int i = tid; i < 3 * 1024; i += NTHREADS) {
        int r = i >> 10, k = i & 1023;
        float v = r < 2 ? P.c[r * D + k] : P.c_ctx[k];
        sc[i] = siluf_(v);
    }
    __syncthreads();
    const float* wsrc = P.w_mod + (size_t)l * D * NMOD + n0 + lane;
    float a0 = 0.f, a1 = 0.f, a2 = 0.f;
#pragma unroll 8
    for (int k = w * 256; k < w * 256 + 256; ++k) {
        float wv = wsrc[(size_t)k * NMOD];
        a0 += sc[k] * wv; a1 += sc[1024 + k] * wv; a2 += sc[2048 + k] * wv;
    }
    red[(w * 3 + 0) * 64 + lane] = a0; red[(w * 3 + 1) * 64 + lane] = a1; red[(w * 3 + 2) * 64 + lane] = a2;
    __syncthreads();
    if (tid < 192) {
        int r = tid >> 6;
        float s = red[(0 * 3 + r) * 64 + lane] + red[(1 * 3 + r) * 64 + lane] + red[(2 * 3 + r) * 64 + lane] + red[(3 * 3 + r) * 64 + lane];
        float* MOD = (float*)(P.ws + OFF_MOD);
        MOD[(size_t)(l * 3 + r) * NMOD + n0 + lane] = s + P.b_mod[(size_t)l * NMOD + n0 + lane];
    }
}

DEVI void tables_item(const Params& P) {
    const int tid = ltid();
    float* RT = (float*)(P.ws + OFF_ROPE);
    float* TW = (float*)(P.ws + OFF_TW);
    for (int i = tid; i < 1024; i += NTHREADS) {
        int p = i >> 3, f = i & 7;
        float fv = f == 0 ? 1.0f : f == 1 ? 0.31622776601683794f : f == 2 ? 0.1f : f == 3 ? 0.03162277660168379f : f == 4 ? 0.01f : f == 5 ? 0.0031622776601683794f : f == 6 ? 0.001f : 0.00031622776601683794f;
        float ang = (float)p * fv;
        double s, c; dsincos((double)ang, s, c);
        RT[i * 2] = (float)c; RT[i * 2 + 1] = (float)s;
    }
    for (int m = tid; m < 4096; m += NTHREADS) {
        double s, c; dsincos(6.283185307179586476925286766559 * (double)m / 8192.0, s, c);
        TW[m * 2] = (float)c; TW[m * 2 + 1] = (float)s;
    }
}

DEVI void prep_phase(const Params& P, int l, bool first, unsigned char* smem) {
    const int n_mod = first ? 288 : 0, n_tab = first ? 1 : 0, n_fold = 64;
    const int total = n_mod + n_tab + n_fold + N_TR_BLOCK_ITEMS;
    const int lane = ltid() & 63, w = ltid() >> 6;
    FOR_ITEMS(it, total) {
        int r = it;
        if (r < n_mod) { mod_item(P, r, smem); continue; }
        r -= n_mod;
        if (r < n_tab) { tables_item(P); continue; }
        r -= n_tab;
        if (r < n_fold) { fold_item(P, l, r, smem); continue; }
        r -= n_fold;
        __syncthreads();
        transpose_dispatch(P, l, r * 4 + w, (float*)smem + w * (64 * 33), lane);
    }
}

DEVI void norm_phase(const Params& P, int nrows, bool first_x, bool has_res, float rscale, const float* g_post, const float* mod_res  , int gate_chunk,
                     bool has_h, const float* g_pre, const float* mod_h, int shift_chunk) {
    const int lane = ltid() & 63, w = ltid() >> 6;
    const bf16* Y = (const bf16*)(P.ws + OFF_Y);
    bf16* H = (bf16*)(P.ws + OFF_H);
    float* XC = (float*)(P.ws + OFF_XC);
    f32x4 cr[4], ch[4], cs[4];
    int cur = -1;
    for (int r = lbid() * 4 + w; r < nrows; r += gridDim.x * 4) {
        const bool lat = r < ML;
        const int mrow = lat ? (r >> 13) : 2;
        if (mrow != cur) {
            cur = mrow;
#pragma unroll
            for (int j = 0; j < 4; ++j) {
                const int c = 4 * lane + 256 * j;
                if (has_res) {
                    f32x4 gp = *(const f32x4*)(g_post + c);
                    f32x4 gt = *(const f32x4*)(mod_res + (size_t)mrow * NMOD + gate_chunk * D + c);
                    cr[j] = (f32x4){gt.x * gp.x * rscale, gt.y * gp.y * rscale, gt.z * gp.z * rscale, gt.w * gp.w * rscale};
                }
                if (has_h) {
                    f32x4 gp = *(const f32x4*)(g_pre + c);
                    f32x4 sh = *(const f32x4*)(mod_h + (size_t)mrow * NMOD + shift_chunk * D + c);
                    f32x4 sc = *(const f32x4*)(mod_h + (size_t)mrow * NMOD + (shift_chunk + 1) * D + c);
                    ch[j] = (f32x4){gp.x * (1.f + sc.x), gp.y * (1.f + sc.y), gp.z * (1.f + sc.z), gp.w * (1.f + sc.w)};
                    cs[j] = sh;
                }
            }
        }
        const float* xin = lat ? ((first_x ? P.x : P.out) + (size_t)r * D) : ((first_x ? P.ctx : XC) + (size_t)(r - ML) * D);
        float* xout = lat ? (P.out + (size_t)r * D) : (XC + (size_t)(r - ML) * D);
        f32x4 v[4];
#pragma unroll
        for (int j = 0; j < 4; ++j) v[j] = *(const f32x4*)(xin + 4 * lane + 256 * j);
        if (has_res) {
            f32x4 y[4];
            float ss = 0.f;
#pragma unroll
            for (int j = 0; j < 4; ++j) {
                v2u u = *(const v2u*)(Y + (size_t)r * D + 4 * lane + 256 * j);
                y[j] = (f32x4){bflo(u.x), bfhi(u.x), bflo(u.y), bfhi(u.y)};
                ss += y[j].x * y[j].x + y[j].y * y[j].y + y[j].z * y[j].z + y[j].w * y[j].w;
            }
#pragma unroll
            for (int o = 1; o < 64; o <<= 1) ss += __shfl_xor(ss, o);
            const float rs = rsqrtf(ss * (1.f / D) + EPS);
#pragma unroll
            for (int j = 0; j < 4; ++j) {
                v[j].x += cr[j].x * (y[j].x * rs); v[j].y += cr[j].y * (y[j].y * rs);
                v[j].z += cr[j].z * (y[j].z * rs); v[j].w += cr[j].w * (y[j].w * rs);
                *(f32x4*)(xout + 4 * lane + 256 * j) = v[j];
            }
        }
        if (has_h) {
            float ss = 0.f;
#pragma unroll
            for (int j = 0; j < 4; ++j) ss += v[j].x * v[j].x + v[j].y * v[j].y + v[j].z * v[j].z + v[j].w * v[j].w;
#pragma unroll
            for (int o = 1; o < 64; o <<= 1) ss += __shfl_xor(ss, o);
            const float rs = rsqrtf(ss * (1.f / D) + EPS);
#pragma unroll
            for (int j = 0; j < 4; ++j) {
                v2u o;
                o.x = pk2(v[j].x * rs * ch[j].x + cs[j].x, v[j].y * rs * ch[j].y + cs[j].y);
                o.y = pk2(v[j].z * rs * ch[j].z + cs[j].z, v[j].w * rs * ch[j].w + cs[j].w);
                *(v2u*)(H + boff(r, 4 * lane + 256 * j, D)) = o;
            }
        }
    }
}

#define EPI_COORDS const int tid = ltid(), lane = tid & 63, wid = tid >> 6, wr = wid >> 1, wc = wid & 1, fr = lane & 15, fq = lane >> 4; (void)tid; (void)wr; (void)wc; (void)fr; (void)fq;

DEVI void gemm_gu_phase(const Params& P, int j, int mtiles, unsigned char* smem) {
    EPI_COORDS
    const bf16* A = (const bf16*)(P.ws + OFF_H);
    const bf16* Bt = (const bf16*)(P.ws + OFF_WGU) + (size_t)j * NGU * D;
    bf16* ACT = (bf16*)(P.ws + OFF_BIG);
    const int NT = NGU / 128, total = mtiles * NT;
    FOR_ITEMS(L, total) {
        int tm, tn; tile_map(L, mtiles, NT, tm, tn);
        f32x4 acc[8][4]; zero_acc<8>(acc);
        gemm_ml<8, 3, true>(A, D, Bt, D, D, tm * 256, tn * 128, smem, acc);
#pragma unroll
        for (int m = 0; m < 8; ++m)
#pragma unroll
            for (int n = 0; n < 2; ++n) {
                int row = tm * 256 + wr * 128 + m * 16 + fr;
                int col = tn * 64 + wc * 32 + n * 16 + fq * 4;
                v2u o;
                o.x = pk2(siluf_(acc[m][n][0]) * acc[m][n + 2][0], siluf_(acc[m][n][1]) * acc[m][n + 2][1]);
                o.y = pk2(siluf_(acc[m][n][2]) * acc[m][n + 2][2], siluf_(acc[m][n][3]) * acc[m][n + 2][3]);
                *(v2u*)(ACT + boff(row, col, DFF)) = o;
            }
    }
}
template <int MB>
DEVI void plain_tile(const bf16* A, int lda, const bf16* Bt, int K, bf16* C, int ldc, int row0, int col0, unsigned char* smem) {
    EPI_COORDS
    f32x4 acc[MB][4]; zero_acc<MB>(acc);
    gemm_ml<MB, 3, true>(A, lda, Bt, K, K, row0, col0, smem, acc);
#pragma unroll
    for (int m = 0; m < MB; ++m)
#pragma unroll
        for (int n = 0; n < 4; ++n) {
            int row = row0 + wr * (MB * 16) + m * 16 + fr;
            int col = col0 + wc * 64 + n * 16 + fq * 4;
            v2u o; o.x = pk2(acc[m][n][0], acc[m][n][1]); o.y = pk2(acc[m][n][2], acc[m][n][3]);
            *(v2u*)(C + (size_t)row * ldc + col) = o;
        }
}
DEVI void gemm_plain_phase(const bf16* A, int lda, const bf16* Bt, int K, bf16* C, int ldc, int rows_big, int rows_small, unsigned char* smem) {
    const int NT = 8, mtb = rows_big / 256, nbig = mtb * NT, total = nbig + (rows_small / 64) * NT;
    FOR_ITEMS(L, total) {
        if (L < nbig) { int tm, tn; tile_map(L, mtb, NT, tm, tn); plain_tile<8>(A, lda, Bt, K, C, ldc, tm * 256, tn * 128, smem); }
        else { int r = L - nbig; plain_tile<2>(A, lda, Bt, K, C, ldc, rows_big + (r >> 3) * 64, (r & 7) * 128, smem); }
    }
}
DEVI float rope_apply(float v, int fr, int p, const float* RT) {
    asm volatile("" : "+v"(p));
    float partner = __shfl_xor(v, 8);
    const float cs = RT[(p * 8 + (fr & 7)) * 2], sn = RT[(p * 8 + (fr & 7)) * 2 + 1];
    return (fr & 8) ? (v * cs + partner * sn) : (v * cs - partner * sn);
}
DEVI void gemm_win_phase(const Params& P, unsigned char* smem) {
    EPI_COORDS
    const bf16* A = (const bf16*)(P.ws + OFF_H);
    const bf16* Bt = (const bf16*)(P.ws + OFF_WIN);
    bf16* Z = (bf16*)(P.ws + OFF_BIG);
    bf16* PT = (bf16*)(P.ws + OFF_Y);
    bf16* KF = (bf16*)(P.ws + OFF_K);
    const float* RT = (const float*)(P.ws + OFF_ROPE);
    const int NT = NWIN / 128, MTL = MT / 256, total = MTL * NT;
    FOR_ITEMS(L, total) {
        int tm, tn; tile_map(L, MTL, NT, tm, tn);
        f32x4 acc[8][4]; zero_acc<8>(acc);
        gemm_ml<8, 3>(A, D, Bt, D, D, tm * 256, tn * 128, smem, acc);
        const int row0 = tm * 256;
        const bool lat = row0 < ML;
        const int b = lat ? (row0 >> 13) : ((row0 - ML) >> 8);
        const int pos0 = lat ? (row0 & (SEQ - 1)) : (SEQ + ((row0 - ML) & (CTXL - 1)));
        if (tn >= 4 && tn < 8) {
            bf16* GVT = (bf16*)(P.ws + OFF_GVT);
#pragma unroll
            for (int m = 0; m < 8; ++m)
#pragma unroll
                for (int n = 0; n < 4; ++n) {
                    int e = wc * 64 + n * 16 + fr;
                    int pos = pos0 + wr * 128 + m * 16 + fq * 4;
                    v2u o; o.x = pk2(acc[m][n][0], acc[m][n][1]); o.y = pk2(acc[m][n][2], acc[m][n][3]);
                    *(v2u*)(GVT + ((size_t)((b * 4 + tn - 4) * 128 + e)) * NPOS + pos) = o;
                }
        } else if (tn < 17) {
#pragma unroll
            for (int m = 0; m < 8; ++m)
#pragma unroll
                for (int n = 0; n < 4; ++n)
#pragma unroll
                    for (int jj = 0; jj < 4; ++jj) {
                        int row = row0 + wr * 128 + m * 16 + fq * 4 + jj;
                        int col = tn * 128 + wc * 64 + n * 16 + fr;
                        Z[(size_t)row * NZ + col] = (bf16)f2bf(acc[m][n][jj]);
                    }
        } else if (tn == 17) {
            if (wc == 0) {
#pragma unroll
                for (int m = 0; m < 8; ++m)
#pragma unroll
                    for (int jj = 0; jj < 4; ++jj) {
                        int lr = wr * 128 + m * 16 + fq * 4 + jj;
                        int row = row0 + lr, pos = pos0 + lr;
#pragma unroll
                        for (int n = 0; n < 2; ++n) Z[(size_t)row * NZ + 2176 + n * 16 + fr] = (bf16)f2bf(acc[m][n][jj]);
                        float v2 = acc[m][2][jj], v3 = acc[m][3][jj];
                        if (lat) { v2 = rope_apply(v2, fr, pos >> 6, RT); v3 = rope_apply(v3, fr, pos & 63, RT); }
                        bf16 h2 = (bf16)f2bf(v2), h3 = (bf16)f2bf(v3);
#pragma unroll
                        for (int h = 0; h < 8; ++h) {
                            bf16* kd = KF + ((size_t)(b * 8 + h) * NPOS + pos) * 96 + 64;
                            kd[fr] = h2; kd[16 + fr] = h3;
                        }
                    }
            }
        } else {
            const int c0 = (tn - 18) * 128 + wc * 64;
#pragma unroll
            for (int m = 0; m < 8; ++m)
#pragma unroll
                for (int n = 0; n < 4; ++n) {
                    int c = c0 + n * 16 + fr;
                    int pos = pos0 + wr * 128 + m * 16 + fq * 4;
                    v2u o; o.x = pk2(acc[m][n][0], acc[m][n][1]); o.y = pk2(acc[m][n][2], acc[m][n][3]);
                    *(v2u*)(PT + ((size_t)(b * 1024 + c)) * NPOS + pos) = o;
                }
        }
    }
}

DEVI void row_rms(const bf16* A, int lda, int K, int row0, float* rsc) {
    const int tid = ltid();
    const int r = tid >> 1, hf = tid & 1;
    const bf16* p = A + (size_t)(row0 + r) * lda + hf * (K / 2);
    float ss = 0.f;
    for (int k = 0; k < K / 2; k += 8) {
        v4u u = *(const v4u*)(p + k);
        float a;
        a = bflo(u.x); ss += a * a; a = bfhi(u.x); ss += a * a; a = bflo(u.y); ss += a * a; a = bfhi(u.y); ss += a * a;
        a = bflo(u.z); ss += a * a; a = bfhi(u.z); ss += a * a; a = bflo(u.w); ss += a * a; a = bfhi(u.w); ss += a * a;
    }
    ss += __shfl_xor(ss, 1);
    if (hf == 0) rsc[r] = rsqrtf(ss / (float)K + EPS);
}

DEVI void mla_q_tile(const Params& P, int tm, int tn, unsigned char* smem) {
    EPI_COORDS
    const bf16* Z = (const bf16*)(P.ws + OFF_BIG);
    bf16* Q = (bf16*)(P.ws + OFF_Q);
    const float* RT = (const float*)(P.ws + OFF_ROPE);
    float* rsc = (float*)(smem + 49152);
    const int row0 = tm * 128;
    __syncthreads();
    row_rms(Z + 1536, NZ, 384, row0, rsc);
    f32x4 acc[4][4]; zero_acc<4>(acc);
    gemm_ml<4, 3, false, false>(Z + 1536, NZ, (const bf16*)(P.ws + OFF_WUQ), 384, 384, row0, tn * 128, smem, acc);
    const bool lat = row0 < ML;
    const int b = lat ? (row0 >> 13) : ((row0 - ML) >> 8);
    const int pos0 = lat ? (row0 & (SEQ - 1)) : (SEQ + ((row0 - ML) & (CTXL - 1)));
    const float qs = 0.10206207261596575f * 1.4426950408889634f;
#pragma unroll
    for (int n = 0; n < 4; ++n) {
        const int c16 = tn * 128 + wc * 64 + n * 16;
        const int h = c16 / 96, d0 = c16 - h * 96;
#pragma unroll
        for (int m = 0; m < 4; ++m)
#pragma unroll
            for (int jj = 0; jj < 4; ++jj) {
                int lr = wr * 64 + m * 16 + fq * 4 + jj;
                int pos = pos0 + lr;
                float v = acc[m][n][jj] * rsc[lr];
                if (lat && d0 >= 64) v = rope_apply(v, fr, d0 == 64 ? (pos >> 6) : (pos & 63), RT);
                Q[((size_t)(b * 8 + h) * NPOS + pos) * 96 + d0 + fr] = (bf16)f2bf(v * qs);
            }
    }
}
DEVI void mla_kv_tile(const Params& P, int tm, int tn, unsigned char* smem) {
    EPI_COORDS
    const bf16* Z = (const bf16*)(P.ws + OFF_BIG);
    bf16* KF = (bf16*)(P.ws + OFF_K);
    bf16* VT = (bf16*)(P.ws + OFF_VT);
    float* rsc = (float*)(smem + 49152);
    const int row0 = tm * 128;
    __syncthreads();
    row_rms(Z + 1920, NZ, 256, row0, rsc);
    f32x4 acc[4][4]; zero_acc<4>(acc);
    gemm_ml<4, 3, false, false>(Z + 1920, NZ, (const bf16*)(P.ws + OFF_WUKV), 256, 256, row0, tn * 128, smem, acc);
    const bool lat = row0 < ML;
    const int b = lat ? (row0 >> 13) : ((row0 - ML) >> 8);
    const int pos0 = lat ? (row0 & (SEQ - 1)) : (SEQ + ((row0 - ML) & (CTXL - 1)));
    const int h = tn;
    if (wc == 0) {
#pragma unroll
        for (int m = 0; m < 4; ++m)
#pragma unroll
            for (int n = 0; n < 4; ++n)
#pragma unroll
                for (int jj = 0; jj < 4; ++jj) {
                    int lr = wr * 64 + m * 16 + fq * 4 + jj;
                    KF[((size_t)(b * 8 + h) * NPOS + pos0 + lr) * 96 + n * 16 + fr] = (bf16)f2bf(acc[m][n][jj] * rsc[lr]);
                }
    } else {
#pragma unroll
        for (int m = 0; m < 4; ++m)
#pragma unroll
            for (int n = 0; n < 4; ++n) {
                int lr = wr * 64 + m * 16 + fq * 4;
                v2u o; o.x = pk2(acc[m][n][0] * rsc[lr], acc[m][n][1] * rsc[lr + 1]); o.y = pk2(acc[m][n][2] * rsc[lr + 2], acc[m][n][3] * rsc[lr + 3]);
                *(v2u*)(VT + ((size_t)(b * 8 + h) * 64 + n * 16 + fr) * NPOS + pos0 + lr) = o;
            }
    }
}

DEVI void fft_item(const bf16* re_src, const bf16* im_src, int N, bf16* dst, int dst_stride, float scale, const float* TW, unsigned char* smem) {
    const int tid = ltid();
    float* re = (float*)smem;
    float* im = re + 8192;
    __syncthreads();
    for (int i = tid; i < N / 8; i += NTHREADS) {
        v4u a = *(const v4u*)(re_src + i * 8), b = *(const v4u*)(im_src + i * 8);
        float* r = re + i * 8; float* q = im + i * 8;
        r[0] = bflo(a.x); r[1] = bfhi(a.x); r[2] = bflo(a.y); r[3] = bfhi(a.y); r[4] = bflo(a.z); r[5] = bfhi(a.z); r[6] = bflo(a.w); r[7] = bfhi(a.w);
        q[0] = bflo(b.x); q[1] = bfhi(b.x); q[2] = bflo(b.y); q[3] = bfhi(b.y); q[4] = bflo(b.z); q[5] = bfhi(b.z); q[6] = bflo(b.w); q[7] = bfhi(b.w);
    }
    __syncthreads();
    const int t4 = N >> 2;
    int p = 1;
    for (; p * 4 <= N; p <<= 2) {
        float xr[8][4], xi[8][4];
#pragma unroll
        for (int u = 0; u < 8; ++u) {
            const int i = tid + NTHREADS * u;
#pragma unroll
            for (int r = 0; r < 4; ++r) {
                if (i < t4) { xr[u][r] = re[i + r * t4]; xi[u][r] = im[i + r * t4]; }
                else { xr[u][r] = 0.f; xi[u][r] = 0.f; }
            }
        }
        __syncthreads();
        const float inv4p = 0.25f / (float)p;
        const bool hoist = (p <= NTHREADS);
        const float rev_h = (float)(tid & (p - 1)) * inv4p;
        const float c_h = __builtin_amdgcn_cosf(rev_h), s_h = __builtin_amdgcn_sinf(rev_h);
#pragma unroll
        for (int u = 0; u < 8; ++u) {
            const int i = tid + NTHREADS * u;
            if (i < t4) {
                const int k = i & (p - 1);
                const int j = ((i - k) << 2) + k;
                float w1r = c_h, w1i = -s_h;
                if (!hoist) { const float rev = (float)k * inv4p; w1r = __builtin_amdgcn_cosf(rev); w1i = -__builtin_amdgcn_sinf(rev); }
                const float w2r = w1r * w1r - w1i * w1i, w2i = 2.f * w1r * w1i;
                const float w3r = w2r * w1r - w2i * w1i, w3i = w2r * w1i + w2i * w1r;
                const float u0r = xr[u][0], u0i = xi[u][0];
                const float u1r = xr[u][1] * w1r - xi[u][1] * w1i, u1i = xr[u][1] * w1i + xi[u][1] * w1r;
                const float u2r = xr[u][2] * w2r - xi[u][2] * w2i, u2i = xr[u][2] * w2i + xi[u][2] * w2r;
                const float u3r = xr[u][3] * w3r - xi[u][3] * w3i, u3i = xr[u][3] * w3i + xi[u][3] * w3r;
                const float v0r = u0r + u2r, v0i = u0i + u2i, v1r = u0r - u2r, v1i = u0i - u2i;
                const float v2r = u1r + u3r, v2i = u1i + u3i, dr = u1r - u3r, di = u1i - u3i;
                const float v3r = di, v3i = -dr;
                re[j] = v0r + v2r;         im[j] = v0i + v2i;
                re[j + p] = v1r + v3r;     im[j + p] = v1i + v3i;
                re[j + 2 * p] = v0r - v2r; im[j + 2 * p] = v0i - v2i;
                re[j + 3 * p] = v1r - v3r; im[j + 3 * p] = v1i - v3i;
            }
        }
        __syncthreads();
    }
    if (p < N) {
        const int half = N >> 1;
        float ar[16], ai[16], br[16], bi[16];
#pragma unroll
        for (int u = 0; u < 16; ++u) {
            int i = tid + NTHREADS * u;
            if (i < half) { ar[u] = re[i]; ai[u] = im[i]; br[u] = re[i + half]; bi[u] = im[i + half]; }
            else { ar[u] = 0.f; ai[u] = 0.f; br[u] = 0.f; bi[u] = 0.f; }
        }
        __syncthreads();
        const float inv2p = 0.5f / (float)p;
#pragma unroll
        for (int u = 0; u < 16; ++u) {
            int i = tid + NTHREADS * u;
            if (i < half) {
                int k = i & (p - 1);
                int j = ((i - k) << 1) + k;
                const float rev = (float)k * inv2p;
                const float c = __builtin_amdgcn_cosf(rev), sn = __builtin_amdgcn_sinf(rev);
                float xr2 = br[u] * c + bi[u] * sn, xi2 = bi[u] * c - br[u] * sn;
                re[j] = ar[u] + xr2; im[j] = ai[u] + xi2; re[j + p] = ar[u] - xr2; im[j + p] = ai[u] - xi2;
            }
        }
        __syncthreads();
    }
    (void)dst_stride;
    for (int i = tid * 8; i < N; i += NTHREADS * 8) {
        const float* r = re + i;
        v4u o; o.x = pk2(r[0] * scale, r[1] * scale); o.y = pk2(r[2] * scale, r[3] * scale); o.z = pk2(r[4] * scale, r[5] * scale); o.w = pk2(r[6] * scale, r[7] * scale);
        *(v4u*)(dst + i) = o;
    }
}

DEVI void ybt_transpose_item(const Params& P, int it, unsigned char* smem) {
    const int tid = ltid();
    int b, pos0, c0;
    if (it < 2048) { b = it >> 10; pos0 = ((it >> 3) & 127) * 64; c0 = (it & 7) * 64; }
    else { int r = it - 2048; b = r >> 5; pos0 = SEQ + ((r >> 3) & 3) * 64; c0 = (r & 7) * 64; }
    const bf16* PT = (const bf16*)(P.ws + OFF_Y);
    bf16* YB = (bf16*)(P.ws + OFF_YB);
    bf16* T = (bf16*)smem;
    __syncthreads();
#pragma unroll
    for (int i = 0; i < 2; ++i) {
        int ch = tid + NTHREADS * i;
        int c = ch >> 3, p8 = (ch & 7) * 8;
        v4u u = *(const v4u*)(PT + ((size_t)(b * 1024 + c0 + c)) * NPOS + pos0 + p8);
        T[(p8 + 0) * 72 + c] = (bf16)(u.x & 0xffff); T[(p8 + 1) * 72 + c] = (bf16)(u.x >> 16);
        T[(p8 + 2) * 72 + c] = (bf16)(u.y & 0xffff); T[(p8 + 3) * 72 + c] = (bf16)(u.y >> 16);
        T[(p8 + 4) * 72 + c] = (bf16)(u.z & 0xffff); T[(p8 + 5) * 72 + c] = (bf16)(u.z >> 16);
        T[(p8 + 6) * 72 + c] = (bf16)(u.w & 0xffff); T[(p8 + 7) * 72 + c] = (bf16)(u.w >> 16);
    }
    __syncthreads();
#pragma unroll
    for (int i = 0; i < 2; ++i) {
        int ch = tid + NTHREADS * i;
        int p = ch >> 3, c8 = (ch & 7) * 8;
        v4u u = *(const v4u*)(T + p * 72 + c8);
        *(v4u*)(YB + boff(row_of_pos(b, pos0 + p), c0 + c8, 512)) = u;
    }
}


template <int MB, int NBk>
DEVI void wave_mma(const bf16* As, int sa, const bf16* Bs, int sb, int K, f32x4 (&acc)[MB][NBk]) {
    const int lane = ltid() & 63, fr = lane & 15, fq = lane >> 4;
    for (int k = 0; k < K; k += 32) {
        bf16x8 a[MB], b[NBk];
#pragma unroll
        for (int m = 0; m < MB; ++m) a[m] = *(const bf16x8*)(As + (m * 16 + fr) * sa + k + fq * 8);
#pragma unroll
        for (int n = 0; n < NBk; ++n) b[n] = *(const bf16x8*)(Bs + (n * 16 + fr) * sb + k + fq * 8);
#pragma unroll
        for (int m = 0; m < MB; ++m)
#pragma unroll
            for (int n = 0; n < NBk; ++n) acc[m][n] = __builtin_amdgcn_mfma_f32_16x16x32_bf16(a[m], b[n], acc[m][n], 0, 0, 0);
    }
}

DEVI int gla_row_base(int b, int dir, int cp) {
    if (cp < 4) { int c = dir ? 3 - cp : cp; return ML + b * CTXL + c * 64; }
    int c = dir ? 131 - cp : cp - 4;
    return b * SEQ + c * 64;
}
DEVI void gla_cumsum(const Params& P, int l, const bf16* Z, int row0, int h, int dir, float* cum, float* abuf) {
    const int tid = ltid();
    for (int i = tid; i < 64 * 16; i += NTHREADS) { int t = i >> 4, r = i & 15; abuf[i] = bf2f(Z[(size_t)(row0 + t) * NZ + 2176 + dir * 16 + r]); }
    __syncthreads();
    const int d = tid & 63, q = tid >> 6;
    float* qtot = abuf + 1024;
    {
        const float* wd = P.gla_wdec + ((size_t)(l * 2 + dir) * 16) * 256 + h * 64 + d;
        float w[16];
#pragma unroll
        for (int r = 0; r < 16; ++r) w[r] = wd[r * 256];
        const float bb = P.gla_bdec[(l * 2 + dir) * 256 + h * 64 + d];
        float run = 0.f;
#pragma unroll 4
        for (int tt = 0; tt < 16; ++tt) {
            const int t = q * 16 + (dir ? 15 - tt : tt);
            const f32x4* ar = (const f32x4*)(abuf + t * 16);
            f32x4 a0 = ar[0], a1 = ar[1], a2 = ar[2], a3 = ar[3];
            float x = bb + a0.x * w[0] + a0.y * w[1] + a0.z * w[2] + a0.w * w[3] + a1.x * w[4] + a1.y * w[5] + a1.z * w[6] + a1.w * w[7]
                      + a2.x * w[8] + a2.y * w[9] + a2.z * w[10] + a2.w * w[11] + a3.x * w[12] + a3.y * w[13] + a3.z * w[14] + a3.w * w[15];
            run += logsigmoidf_(x) * (1.f / 16.f);
            cum[t * 64 + d] = run;
        }
        qtot[q * 64 + d] = run;
    }
    __syncthreads();
    {
        float off = 0.f;
        if (dir == 0) { for (int qq = 0; qq < q; ++qq) off += qtot[qq * 64 + d]; }
        else { for (int qq = 3; qq > q; --qq) off += qtot[qq * 64 + d]; }
#pragma unroll 4
        for (int tt = 0; tt < 16; ++tt) cum[(q * 16 + tt) * 64 + d] += off;
    }
    __syncthreads();
}
constexpr int GS = 72;
DEVI void gla_load_vt(const Params& P, int b, int h, int pos0, bf16* VTs) {
    const int tid = ltid();
    const bf16* G = (const bf16*)(P.ws + OFF_GVT) + (size_t)((b * 4 + h) * 128) * NPOS + pos0;
#pragma unroll
    for (int i = 0; i < 4; ++i) {
        int c = tid + NTHREADS * i;
        int e = c >> 3, part = c & 7;
        *(v4u*)(VTs + e * GS + part * 8) = *(const v4u*)(G + (size_t)e * NPOS + part * 8);
    }
}
DEVI void gla_local_item(const Params& P, int l, int it, unsigned char* smem) {
    const int tid = ltid(), lane = tid & 63, w = tid >> 6, fr = lane & 15, fq = lane >> 4;
    const int chain = it / 132, cp = it - chain * 132;
    const int b = chain >> 3, h = (chain >> 1) & 3, dir = chain & 1;
    const int row0 = gla_row_base(b, dir, cp);
    const bf16* Z = (const bf16*)(P.ws + OFF_BIG);
    float* cum = (float*)smem;
    bf16* VTs = (bf16*)(smem + 16384);
    bf16* KTs = (bf16*)(smem + 16384 + 128 * GS * 2);
    float* abuf = (float*)(smem + 16384 + 192 * GS * 2);
    __syncthreads();
    gla_cumsum(P, l, Z, row0, h, dir, cum, abuf);
    gla_load_vt(P, b, h, row0 < ML ? (row0 & (SEQ - 1)) : SEQ + ((row0 - ML) & (CTXL - 1)), VTs);
    const int tl = dir ? 0 : 63;
#pragma unroll
    for (int i = 0; i < 2; ++i) {
        int c = tid + NTHREADS * i;
        int s = c >> 3, d0 = (c & 7) * 8;
        v4u u = *(const v4u*)(Z + (size_t)(row0 + s) * NZ + 256 + h * 64 + d0);
        float kv[8] = {bflo(u.x), bfhi(u.x), bflo(u.y), bfhi(u.y), bflo(u.z), bfhi(u.z), bflo(u.w), bfhi(u.w)};
#pragma unroll
        for (int q = 0; q < 8; ++q) KTs[(d0 + q) * GS + s] = (bf16)f2bf(kv[q] * __expf(cum[tl * 64 + d0 + q] - cum[s * 64 + d0 + q]));
    }
    if (tid < 64) ((float*)(P.ws + OFF_DEC))[(size_t)(chain * 132 + cp) * 64 + tid] = __expf(cum[tl * 64 + tid]);
    __syncthreads();
    f32x4 acc[2][4];
#pragma unroll
    for (int m = 0; m < 2; ++m)
#pragma unroll
        for (int n = 0; n < 4; ++n) acc[m][n] = (f32x4){0.f, 0.f, 0.f, 0.f};
    wave_mma<2, 4>(VTs + (w * 32) * GS, GS, KTs, GS, 64, acc);
    bf16* ST = (bf16*)(P.ws + OFF_Y) + (size_t)(chain * 132 + cp) * 8192;
#pragma unroll
    for (int m = 0; m < 2; ++m)
#pragma unroll
        for (int n = 0; n < 4; ++n)
#pragma unroll
            for (int jj = 0; jj < 4; ++jj) ST[(w * 32 + m * 16 + fq * 4 + jj) * 64 + n * 16 + fr] = (bf16)f2bf(acc[m][n][jj]);
}
DEVI void gla_scan_phase(const Params& P) {
    bf16* ST = (bf16*)(P.ws + OFF_Y);
    const float* DEC = (const float*)(P.ws + OFF_DEC);
    for (int g = lbid() * NTHREADS + ltid(); g < 16 * 2048; g += gridDim.x * NTHREADS) {
        const int chain = g >> 11, idx = (g & 2047) * 4, d = idx & 63;
        bf16* p = ST + (size_t)chain * 132 * 8192 + idx;
        const float* dc = DEC + (size_t)chain * 132 * 64 + d;
        float S0 = 0.f, S1 = 0.f, S2 = 0.f, S3 = 0.f;
        for (int c0 = 0; c0 < 132; c0 += 12) {
            v2u Lv[12]; f32x4 dv[12];
#pragma unroll
            for (int u = 0; u < 12; ++u) { Lv[u] = *(const v2u*)(p + (size_t)(c0 + u) * 8192); dv[u] = *(const f32x4*)(dc + (c0 + u) * 64); }
#pragma unroll
            for (int u = 0; u < 12; ++u) {
                v2u o; o.x = pk2(S0, S1); o.y = pk2(S2, S3);
                *(v2u*)(p + (size_t)(c0 + u) * 8192) = o;
                S0 = dv[u].x * S0 + bflo(Lv[u].x); S1 = dv[u].y * S1 + bfhi(Lv[u].x);
                S2 = dv[u].z * S2 + bflo(Lv[u].y); S3 = dv[u].w * S3 + bfhi(Lv[u].y);
            }
        }
    }
}
DEVI void gla_out_item(const Params& P, int l, int it, bool skip_ctx, unsigned char* smem) {
    const int tid = ltid(), lane = tid & 63, w = tid >> 6, fr = lane & 15, fq = lane >> 4;
    const int bh = it / 132, ci = it - bh * 132;
    if (skip_ctx && ci < 4) return;
    const int b = bh >> 2, h = bh & 3;
    const int row0 = ci < 4 ? ML + b * CTXL + ci * 64 : b * SEQ + (ci - 4) * 64;
    const bf16* Z = (const bf16*)(P.ws + OFF_BIG);
    float* cum = (float*)smem;
    bf16* Pw = (bf16*)smem + w * 16 * GS;
    bf16* QA = (bf16*)(smem + 16384);
    bf16* KB = QA + 64 * GS;
    bf16* VTs = KB + 64 * GS;
    float* abuf = (float*)(smem + 16384 + 256 * GS * 2);
    f32x4 O[1][8];
#pragma unroll
    for (int n = 0; n < 8; ++n) O[0][n] = (f32x4){0.f, 0.f, 0.f, 0.f};
    __syncthreads();
    gla_load_vt(P, b, h, ci < 4 ? SEQ + ci * 64 : (ci - 4) * 64, VTs);
    for (int dir = 0; dir < 2; ++dir) {
        const int chain = (b * 4 + h) * 2 + dir;
        const int cp = dir ? (ci < 4 ? 3 - ci : 135 - ci) : ci;
        gla_cumsum(P, l, Z, row0, h, dir, cum, abuf);
#pragma unroll
        for (int i = 0; i < 2; ++i) {
            int c = tid + NTHREADS * i;
            int s = c >> 3, d0 = (c & 7) * 8;
            v4u uq = *(const v4u*)(Z + (size_t)(row0 + s) * NZ + h * 64 + d0);
            v4u uk = *(const v4u*)(Z + (size_t)(row0 + s) * NZ + 256 + h * 64 + d0);
            float qv[8] = {bflo(uq.x), bfhi(uq.x), bflo(uq.y), bfhi(uq.y), bflo(uq.z), bfhi(uq.z), bflo(uq.w), bfhi(uq.w)};
            float kv[8] = {bflo(uk.x), bfhi(uk.x), bflo(uk.y), bfhi(uk.y), bflo(uk.z), bfhi(uk.z), bflo(uk.w), bfhi(uk.w)};
            unsigned qo[4], ko[4];
#pragma unroll
            for (int q = 0; q < 4; ++q) {
                float c0 = cum[s * 64 + d0 + 2 * q], c1 = cum[s * 64 + d0 + 2 * q + 1];
                qo[q] = pk2(qv[2 * q] * 0.125f * __expf(c0), qv[2 * q + 1] * 0.125f * __expf(c1));
                ko[q] = pk2(kv[2 * q] * __expf(-c0), kv[2 * q + 1] * __expf(-c1));
            }
            *(v4u*)(QA + s * GS + d0) = (v4u){qo[0], qo[1], qo[2], qo[3]};
            *(v4u*)(KB + s * GS + d0) = (v4u){ko[0], ko[1], ko[2], ko[3]};
        }
        __syncthreads();
        f32x4 S[1][4];
#pragma unroll
        for (int n = 0; n < 4; ++n) S[0][n] = (f32x4){0.f, 0.f, 0.f, 0.f};
        wave_mma<1, 4>(QA + (w * 16) * GS, GS, KB, GS, 64, S);
#pragma unroll
        for (int n = 0; n < 4; ++n)
#pragma unroll
            for (int jj = 0; jj < 4; ++jj) {
                int t = w * 16 + fq * 4 + jj, s = n * 16 + fr;
                bool keep = dir ? (s >= t) : (s <= t);
                Pw[(fq * 4 + jj) * GS + s] = (bf16)f2bf(keep ? S[0][n][jj] : 0.f);
            }
        LDS_WAIT();
        __builtin_amdgcn_wave_barrier();
        wave_mma<1, 8>(Pw, GS, VTs, GS, 64, O);
        {
            const bf16* Sin = (const bf16*)(P.ws + OFF_Y) + (size_t)(chain * 132 + cp) * 8192;
#pragma unroll
            for (int ks = 0; ks < 2; ++ks) {
                bf16x8 a = *(const bf16x8*)(QA + (w * 16 + fr) * GS + ks * 32 + fq * 8);
#pragma unroll
                for (int n = 0; n < 8; ++n) {
                    bf16x8 bb = *(const bf16x8*)(Sin + (n * 16 + fr) * 64 + ks * 32 + fq * 8);
                    O[0][n] = __builtin_amdgcn_mfma_f32_16x16x32_bf16(a, bb, O[0][n], 0, 0, 0);
                }
            }
        }
        __syncthreads();
    }
    float ss[4];
#pragma unroll
    for (int jj = 0; jj < 4; ++jj) {
        float s = 0.f;
#pragma unroll
        for (int n = 0; n < 8; ++n) s += O[0][n][jj] * O[0][n][jj];
        s += __shfl_xor(s, 1); s += __shfl_xor(s, 2); s += __shfl_xor(s, 4); s += __shfl_xor(s, 8);
        ss[jj] = rsqrtf(s * (1.f / 128.f) + EPS);
    }
    bf16* YA = (bf16*)(P.ws + OFF_YA);
    const float* gn = P.gla_norm + l * 128;
#pragma unroll
    for (int n = 0; n < 8; ++n) {
        const int e = n * 16 + fr;
        const float gnv = gn[e];
#pragma unroll
        for (int jj = 0; jj < 4; ++jj) {
            int row = row0 + w * 16 + fq * 4 + jj;
            float gv = bf2f(Z[(size_t)row * NZ + 1024 + h * 128 + e]);
            YA[boff(row, h * 128 + e, 512)] = (bf16)f2bf(O[0][n][jj] * ss[jj] * gnv * siluf_(gv));
        }
    }
}

constexpr int KS_STRIDE = 104, VS_STRIDE = 72;
constexpr int ATT_BUF = 64 * KS_STRIDE * 2 + 64 * VS_STRIDE * 2;
DEVI void attn_item(const Params& P, int b, int h, int q0  , int k_lo, int k_hi, unsigned char* smem) {
    const int tid = ltid(), lane = tid & 63, w = tid >> 6, fr = lane & 15, fq = lane >> 4;
    const bf16* Q = (const bf16*)(P.ws + OFF_Q) + (size_t)(b * 8 + h) * NPOS * 96;
    const bf16* KF = (const bf16*)(P.ws + OFF_K) + (size_t)(b * 8 + h) * NPOS * 96;
    const bf16* VT = (const bf16*)(P.ws + OFF_VT) + (size_t)(b * 8 + h) * 64 * NPOS;
    bf16x8 Qf[2][3];
#pragma unroll
    for (int mi = 0; mi < 2; ++mi)
#pragma unroll
        for (int ks = 0; ks < 3; ++ks) Qf[mi][ks] = *(const bf16x8*)(Q + (size_t)(q0 + w * 32 + mi * 16 + fr) * 96 + ks * 32 + fq * 8);
    f32x4 O[2][4];
    float mrun[2], lrun[2];
#pragma unroll
    for (int mi = 0; mi < 2; ++mi) {
#pragma unroll
        for (int n = 0; n < 4; ++n) O[mi][n] = (f32x4){0.f, 0.f, 0.f, 0.f};
        mrun[mi] = 0.f; lrun[mi] = 0.f;
    }
    int kg[3], kl[3], vg[2], vl[2];
#pragma unroll
    for (int i = 0; i < 3; ++i) { int c = tid + NTHREADS * i; int key = c / 12, part = c - key * 12; kg[i] = key * 96 + part * 8; kl[i] = key * KS_STRIDE + part * 8; }
#pragma unroll
    for (int i = 0; i < 2; ++i) { int c = tid + NTHREADS * i; int dv = c >> 3, part = c & 7; vg[i] = dv * NPOS + part * 8; vl[i] = 64 * KS_STRIDE + dv * VS_STRIDE + part * 8; }
    v4u kr[3], vr[2];
#pragma unroll
    for (int i = 0; i < 3; ++i) kr[i] = *(const v4u*)(KF + (size_t)k_lo * 96 + kg[i]);
#pragma unroll
    for (int i = 0; i < 2; ++i) vr[i] = *(const v4u*)(VT + k_lo + vg[i]);
    __syncthreads();
    {
        bf16* B0 = (bf16*)smem;
#pragma unroll
        for (int i = 0; i < 3; ++i) *(v4u*)(B0 + kl[i]) = kr[i];
#pragma unroll
        for (int i = 0; i < 2; ++i) *(v4u*)(B0 + vl[i]) = vr[i];
    }
    __syncthreads();
    int cur = 0;
    for (int k0 = k_lo; k0 < k_hi; k0 += 64) {
        const bool more = (k0 + 64 < k_hi);
        const bf16* Ks = (const bf16*)(smem + cur * ATT_BUF);
        const bf16* Vs = Ks + 64 * KS_STRIDE;
        f32x4 S[2][4];
#pragma unroll
        for (int mi = 0; mi < 2; ++mi)
#pragma unroll
            for (int n = 0; n < 4; ++n) { const float nm = -mrun[mi]; S[mi][n] = (f32x4){nm, nm, nm, nm}; }
#pragma unroll
        for (int ks = 0; ks < 3; ++ks) {
            bf16x8 kf[4];
#pragma unroll
            for (int n = 0; n < 4; ++n) kf[n] = *(const bf16x8*)(Ks + (n * 16 + fr) * KS_STRIDE + ks * 32 + fq * 8);
#pragma unroll
            for (int mi = 0; mi < 2; ++mi)
#pragma unroll
                for (int n = 0; n < 4; ++n) S[mi][n] = __builtin_amdgcn_mfma_f32_16x16x32_bf16(kf[n], Qf[mi][ks], S[mi][n], 0, 0, 0);
        }
        if (more) {
#pragma unroll
            for (int i = 0; i < 3; ++i) kr[i] = *(const v4u*)(KF + (size_t)(k0 + 64) * 96 + kg[i]);
#pragma unroll
            for (int i = 0; i < 2; ++i) vr[i] = *(const v4u*)(VT + (k0 + 64) + vg[i]);
        }
        bf16x8 vf0[4], vf1[4];
#pragma unroll
        for (int n = 0; n < 4; ++n) {
            v2u lo = *(const v2u*)(Vs + (n * 16 + fr) * VS_STRIDE + fq * 4);
            v2u hi = *(const v2u*)(Vs + (n * 16 + fr) * VS_STRIDE + 16 + fq * 4);
            v4u vv = (v4u){lo.x, lo.y, hi.x, hi.y};
            vf0[n] = __builtin_bit_cast(bf16x8, vv);
        }
        const bool first = (k0 == k_lo);
        float mx[2];
#pragma unroll
        for (int mi = 0; mi < 2; ++mi) {
            float m0 = fmaxf(fmaxf(S[mi][0][0], S[mi][0][1]), fmaxf(S[mi][0][2], S[mi][0][3]));
#pragma unroll
            for (int n = 1; n < 4; ++n) m0 = fmaxf(m0, fmaxf(fmaxf(S[mi][n][0], S[mi][n][1]), fmaxf(S[mi][n][2], S[mi][n][3])));
            m0 = fmaxf(m0, __shfl_xor(m0, 16));
            m0 = fmaxf(m0, __shfl_xor(m0, 32));
            mx[mi] = m0;
        }
        if (__any(first || mx[0] > 8.f || mx[1] > 8.f)) {
#pragma unroll
            for (int mi = 0; mi < 2; ++mi) {
                const bool upd = first || mx[mi] > 8.f;
                const float dm = upd ? mx[mi] : 0.f;
                const float alpha = first ? 0.f : __builtin_amdgcn_exp2f(-dm);
                mrun[mi] += dm;
                lrun[mi] *= alpha;
#pragma unroll
                for (int n = 0; n < 4; ++n) {
                    O[mi][n][0] *= alpha; O[mi][n][1] *= alpha; O[mi][n][2] *= alpha; O[mi][n][3] *= alpha;
                    S[mi][n][0] -= dm; S[mi][n][1] -= dm; S[mi][n][2] -= dm; S[mi][n][3] -= dm;
                }
            }
        }
        float psum[2] = {0.f, 0.f};
#pragma unroll
        for (int s2 = 0; s2 < 2; ++s2) {
            bf16x8 Pb[2];
#pragma unroll
            for (int mi = 0; mi < 2; ++mi) {
#pragma unroll
                for (int n = 2 * s2; n < 2 * s2 + 2; ++n)
#pragma unroll
                    for (int jj = 0; jj < 4; ++jj) { float p = __builtin_amdgcn_exp2f(S[mi][n][jj]); S[mi][n][jj] = p; psum[mi] += p; }
                const v4u pk = pack8_for_mfma(S[mi][2 * s2][0], S[mi][2 * s2][1], S[mi][2 * s2][2], S[mi][2 * s2][3],
                                              S[mi][2 * s2 + 1][0], S[mi][2 * s2 + 1][1], S[mi][2 * s2 + 1][2], S[mi][2 * s2 + 1][3]);
                Pb[mi] = __builtin_bit_cast(bf16x8, pk);
            }
            if (s2 == 0) {
#pragma unroll
                for (int n = 0; n < 4; ++n) {
                    v2u lo = *(const v2u*)(Vs + (n * 16 + fr) * VS_STRIDE + 32 + fq * 4);
                    v2u hi = *(const v2u*)(Vs + (n * 16 + fr) * VS_STRIDE + 48 + fq * 4);
                    v4u vv = (v4u){lo.x, lo.y, hi.x, hi.y};
                    vf1[n] = __builtin_bit_cast(bf16x8, vv);
                }
            }
            __builtin_amdgcn_s_setprio(1);
#pragma unroll
            for (int n = 0; n < 4; ++n) {
                const bf16x8 vf = (s2 == 0) ? vf0[n] : vf1[n];
#pragma unroll
                for (int mi = 0; mi < 2; ++mi) O[mi][n] = __builtin_amdgcn_mfma_f32_16x16x32_bf16(vf, Pb[mi], O[mi][n], 0, 0, 0);
            }
            __builtin_amdgcn_s_setprio(0);
        }
        lrun[0] += psum[0]; lrun[1] += psum[1];
        if (more) {
            bf16* Bn = (bf16*)(smem + (cur ^ 1) * ATT_BUF);
#pragma unroll
            for (int i = 0; i < 3; ++i) *(v4u*)(Bn + kl[i]) = kr[i];
#pragma unroll
            for (int i = 0; i < 2; ++i) *(v4u*)(Bn + vl[i]) = vr[i];
        }
        __syncthreads();
        cur ^= 1;
    }
    bf16* YC = (bf16*)(P.ws + OFF_YC);
#pragma unroll
    for (int mi = 0; mi < 2; ++mi) {
        float l = lrun[mi];
        l += __shfl_xor(l, 16); l += __shfl_xor(l, 32);
        const float inv = 1.f / l;
        const int pos = q0 + w * 32 + mi * 16 + fr;
        const int row = row_of_pos(b, pos);
#pragma unroll
        for (int n = 0; n < 4; ++n) {
            v2u o; o.x = pk2(O[mi][n][0] * inv, O[mi][n][1] * inv); o.y = pk2(O[mi][n][2] * inv, O[mi][n][3] * inv);
            *(v2u*)(YC + boff(row, h * 64 + n * 16 + fq * 4, 512)) = o;
        }
    }
}

template <int MB>
DEVI void merge_tile(const Params& P, int row0, int col0, unsigned char* smem) {
    EPI_COORDS
    const bf16* H = (const bf16*)(P.ws + OFF_H);
    const bf16* WG = (const bf16*)(P.ws + OFF_WGATE);
    const bf16* WB = (const bf16*)(P.ws + OFF_WBR);
    bf16* M1 = (bf16*)(P.ws + OFF_BIG);
    f32x4 tot[MB][4]; zero_acc<MB>(tot);
    for (int i = 0; i < 3; ++i) {
        f32x4 acc[MB][4]; zero_acc<MB>(acc);
        gemm_ml<MB, 3>(H, D, WG + (size_t)i * D * D, D, D, row0, col0, smem, acc);
        unsigned gpr[2][4][2];
        unsigned* gpl = (unsigned*)(smem + 49152) + tid;
#pragma unroll
        for (int m = 0; m < MB; ++m)
#pragma unroll
            for (int n = 0; n < 4; ++n) {
                const unsigned g0 = pk2(sigmoidf_(acc[m][n][0]), sigmoidf_(acc[m][n][1]));
                const unsigned g1 = pk2(sigmoidf_(acc[m][n][2]), sigmoidf_(acc[m][n][3]));
                if (m < 2) { gpr[m][n][0] = g0; gpr[m][n][1] = g1; }
                else { gpl[((m - 2) * 8 + n * 2 + 0) * NTHREADS] = g0; gpl[((m - 2) * 8 + n * 2 + 1) * NTHREADS] = g1; }
            }
        zero_acc<MB>(acc);
        const bf16* Yi = (const bf16*)(P.ws + (i == 0 ? OFF_YA : i == 1 ? OFF_YB : OFF_YC));
        gemm_ml<MB, 3>(Yi, 512, WB + (size_t)i * D * 512, 512, 512, row0, col0, smem, acc);
#pragma unroll
        for (int m = 0; m < MB; ++m)
#pragma unroll
            for (int n = 0; n < 4; ++n) {
                unsigned g0, g1;
                if (m < 2) { g0 = gpr[m][n][0]; g1 = gpr[m][n][1]; }
                else { g0 = gpl[((m - 2) * 8 + n * 2 + 0) * NTHREADS]; g1 = gpl[((m - 2) * 8 + n * 2 + 1) * NTHREADS]; }
                tot[m][n][0] += bflo(g0) * acc[m][n][0]; tot[m][n][1] += bfhi(g0) * acc[m][n][1];
                tot[m][n][2] += bflo(g1) * acc[m][n][2]; tot[m][n][3] += bfhi(g1) * acc[m][n][3];
            }
    }
#pragma unroll
    for (int m = 0; m < MB; ++m)
#pragma unroll
        for (int n = 0; n < 4; ++n)
#pragma unroll
            for (int jj = 0; jj < 4; ++jj) {
                int row = row0 + wr * (MB * 16) + m * 16 + fq * 4 + jj;
                int col = col0 + wc * 64 + n * 16 + fr;
                M1[boff(row, col, D)] = (bf16)f2bf(tot[m][n][jj]);
            }
}
DEVI void merge_phase(const Params& P, bool with_ctx, unsigned char* smem) {
    const int nbig = (ML / 128) * 8, total = nbig + (with_ctx ? (MC / 64) * 8 : 0);
    FOR_ITEMS(L, total) {
        if (L < nbig) { int tm, tn; tile_map(L, ML / 128, 8, tm, tn); merge_tile<4>(P, tm * 128, tn * 128, smem); }
        else { int r = L - nbig; merge_tile<2>(P, ML + (r >> 3) * 64, (r & 7) * 128, smem); }
    }
}

#define XB_TMO      128
#define XB_XCNT(j)  (256  + 64 * (j))
#define XB_XSUB(j)  (1280 + 64 * (j))
#define XB_XGEN(j)  (2304 + 64 * (j))
#define XB_TOP      3328
#define XB_TOPGEN   3392
#define XCD_BAR_WORDS 3456
#define XB_SPIN_CAP (1u << 18)
DEVI unsigned xb_ld(unsigned* p)              { return __hip_atomic_load(p, __ATOMIC_RELAXED, __HIP_MEMORY_SCOPE_AGENT); }
DEVI unsigned xb_add(unsigned* p, unsigned v) { return __hip_atomic_fetch_add(p, v, __ATOMIC_RELAXED, __HIP_MEMORY_SCOPE_AGENT); }
DEVI unsigned xb_xcc_id() { return (unsigned)__builtin_amdgcn_s_getreg((3 << 11) | 20) & 0xFu; }
#define XB_SPIN(cond, bar) do { unsigned _sp = 0; while (cond) { __builtin_amdgcn_s_sleep(1); \
    if ((++_sp & 255u) == 0u) { if (xb_ld(&(bar)[XB_TMO])) break; if (_sp > XB_SPIN_CAP) { atomicAdd(&(bar)[XB_TMO], 1u); break; } } } } while (0)
struct XcdBarrier { unsigned* bar; unsigned x; volatile LAS unsigned* st; };
DEVI XcdBarrier xcd_barrier_post(unsigned* bar, volatile LAS unsigned* st) {
    XcdBarrier b; b.bar = bar; b.x = xb_xcc_id(); b.st = st;
    if (threadIdx.x == 0) (void)xb_add(&bar[XB_XCNT(b.x)], 1u);
    return b;
}
DEVI void xcd_barrier_complete(unsigned* bar, unsigned x, unsigned& nloc, unsigned& nx) {
    const unsigned G = gridDim.x * gridDim.y * gridDim.z;
    unsigned sum, cnt, mine, sp = 0u;
    for (;;) {
        sum = 0u; cnt = 0u; mine = 0u;
#pragma unroll
        for (unsigned j = 0; j < 16; ++j) { const unsigned c = xb_ld(&bar[XB_XCNT(j)]); sum += c; cnt += (c > 0u) ? 1u : 0u; mine = (j == x) ? c : mine; }
        if (sum == G) break;
        __builtin_amdgcn_s_sleep(1);
        if ((++sp & 255u) == 0u) { if (xb_ld(&bar[XB_TMO])) break; if (sp > XB_SPIN_CAP) { atomicAdd(&bar[XB_TMO], 1u); break; } }
    }
    nloc = mine > 0u ? mine : 1u; nx = cnt > 0u ? cnt : 1u;
}
DEVI void xcd_barrier(const XcdBarrier& b) {
    asm volatile("s_waitcnt vmcnt(0)" ::: "memory");
    __syncthreads();
    if (threadIdx.x == 0) {
        unsigned* bar = b.bar;
        __builtin_amdgcn_s_waitcnt(0);
        unsigned nloc = b.st[0], nx = b.st[1];
        if (nloc == 0u) { xcd_barrier_complete(bar, b.x, nloc, nx); b.st[0] = nloc; b.st[1] = nx; }
        const unsigned old = xb_add(&bar[XB_XSUB(b.x)], 1u);
        const unsigned gen = old / nloc;
        if (old + 1u == (gen + 1u) * nloc) {
            __builtin_amdgcn_fence(__ATOMIC_RELEASE, "agent");
            asm volatile("s_waitcnt vmcnt(0)" ::: "memory");
            const unsigned og = xb_add(&bar[XB_TOP], 1u);
            const unsigned tg = og / nx;
            if (og + 1u == (tg + 1u) * nx) xb_add(&bar[XB_TOPGEN], 1u);
            else XB_SPIN(xb_ld(&bar[XB_TOPGEN]) == tg, bar);
            __builtin_amdgcn_fence(__ATOMIC_ACQUIRE, "agent");
            xb_add(&bar[XB_XGEN(b.x)], 1u);
            asm volatile("s_waitcnt vmcnt(0)" ::: "memory");
        } else {
            XB_SPIN(xb_ld(&bar[XB_XGEN(b.x)]) == gen, bar);
            __builtin_amdgcn_fence(__ATOMIC_ACQUIRE, "agent");
            asm volatile("s_waitcnt vmcnt(0)" ::: "memory");
        }
    }
    __syncthreads();
}

__global__ void __launch_bounds__(NTHREADS, 2) mega(Params P0) {
    extern __shared__ __attribute__((aligned(16))) unsigned char smem[];
    volatile LAS unsigned* bst = (volatile LAS unsigned*)(smem + LDS_MAIN);
    if (threadIdx.x < 2) bst[threadIdx.x] = 0u;
    __syncthreads();
    XcdBarrier xbar; xbar.bar = (unsigned*)(P0.ws + OFF_BAR); xbar.x = 0; xbar.st = bst;
    if (P0.coop == 1) xbar = xcd_barrier_post((unsigned*)(P0.ws + OFF_BAR), bst);
    for (int ph = P0.ph_lo; ph < P0.ph_hi; ++ph) {
        Params P = P0;
        {
            size_t z = 0;
            asm volatile("" : "+s"(z));
            const float** pp = (const float**)&P;
#pragma unroll
            for (int i = 0; i < 21; ++i) pp[i] = pp[i] + z;
            P.out = P.out + z; P.ws = P.ws + z;
        }
        unsigned char* ws = P.ws;
        const float* MOD = (const float*)(ws + OFF_MOD);
#if DUP_MASK
        const int nrep = (ph >= 2 && ((DUP_MASK >> ((ph - 2) % 15)) & 1)) ? 2 : 1;
        for (int rep = 0; rep < nrep; ++rep) {
        if (rep) xcd_barrier(xbar);
#endif
        if (ph == 0) {
            prep_phase(P, 0, true, smem);
        } else if (ph == 1) {
            norm_phase(P, MT, true, false, 0.f, nullptr, nullptr, 0, true, P.norm_pre + 0 * D, MOD, 0);
        } else {
            const int l = (ph - 2) / 15, s = (ph - 2) % 15;
            const bool last = (l == 1);
            const float* modl = MOD + (size_t)l * 3 * NMOD;
            const int mrows = last ? ML : MT;
            switch (s) {
            case 0: gemm_gu_phase(P, 0, MT / 256, smem); break;
            case 1: gemm_plain_phase((const bf16*)(ws + OFF_BIG), DFF, (const bf16*)(ws + OFF_WD), DFF, (bf16*)(ws + OFF_Y), D, ML, MC, smem); break;
            case 2: norm_phase(P, MT, l == 0, true, 0.5f, P.norm_post + (l * 3 + 0) * D, modl, 2, true, P.norm_pre + (l * 3 + 1) * D, modl, 3); break;
            case 3: gemm_win_phase(P, smem); break;
            case 4: {
                const int n_fft = last ? 1024 : 2048, n_q = 132 * 6, n_kv = 132 * 8;
                const int total = n_fft + n_q + n_kv;
                const float* TW = (const float*)(ws + OFF_TW);
                const bf16* PT = (const bf16*)(ws + OFF_Y);
                FOR_ITEMS(it, total) {
                    int r = it;
                    if (r < n_fft) {
                        const int isc = r >> 10, cc = r & 1023, b = cc >> 9, c = cc & 511;
                        const bf16* re = PT + ((size_t)(b * 1024 + c)) * NPOS + (isc ? SEQ : 0);
                        const bf16* im = re + (size_t)512 * NPOS;
                        if (!isc) fft_item(re, im, SEQ, (bf16*)re, 1, 9.765625e-4f  , TW, smem);
                        else fft_item(re, im, CTXL, (bf16*)re, 1, 5.524271728019903e-3f  , TW, smem);
                        continue;
                    }
                    r -= n_fft;
                    if (r < n_q) { mla_q_tile(P, r / 6, r % 6, smem); continue; }
                    r -= n_q;
                    mla_kv_tile(P, r >> 3, r & 7, smem);
                }
            } break;
            case 5: {
                const int n_tr = last ? 2048 : 2112, n_al = 2 * 8 * 64, n_ac = last ? 0 : 2 * 8 * 2;
                const int total = n_tr + n_al + n_ac;
                FOR_ITEMS(it, total) {
                    int r = it;
                    if (r < n_tr) { ybt_transpose_item(P, r, smem); continue; }
                    r -= n_tr;
                    if (r < n_al) { attn_item(P, r >> 9, (r >> 6) & 7, (r & 63) * 128, 0, NPOS, smem); continue; }
                    r -= n_al;
                    attn_item(P, r >> 4, (r >> 1) & 7, SEQ + (r & 1) * 128, SEQ, NPOS, smem);
                }
            } break;
            case 6:
                FOR_ITEMS(it, 16 * 132) gla_local_item(P, l, it, smem);
                break;
            case 7: gla_scan_phase(P); break;
            case 8:
                FOR_ITEMS(it, 8 * 132) gla_out_item(P, l, it, last, smem);
                break;
            case 9: merge_phase(P, !last, smem); break;
            case 10: gemm_plain_phase((const bf16*)(ws + OFF_BIG), D, (const bf16*)(ws + OFF_WOUT), D, (bf16*)(ws + OFF_Y), D, ML, last ? 0 : MC, smem); break;
            case 11: norm_phase(P, mrows, false, true, 1.0f, P.norm_post + (l * 3 + 1) * D, modl, 5, true, P.norm_pre + (l * 3 + 2) * D, modl, 6); break;
            case 12: gemm_gu_phase(P, 1, mrows / 256, smem); break;
            case 13: gemm_plain_phase((const bf16*)(ws + OFF_BIG), DFF, (const bf16*)(ws + OFF_WD) + (size_t)D * DFF, DFF, (bf16*)(ws + OFF_Y), D, ML, last ? 0 : MC, smem); break;
            case 14:
                norm_phase(P, mrows, false, true, 0.5f, P.norm_post + (l * 3 + 2) * D, modl, 8, !last, P.norm_pre + ((l + 1) * 3 + 0) * D, MOD + (size_t)(l + 1) * 3 * NMOD, 0);
                if (!last) prep_phase(P, 1, false, smem);
                break;
            }
        }
#if DUP_MASK
        }
#endif
        if (ph + 1 < P0.ph_hi) { if (P0.coop == 1) xcd_barrier(xbar); else if (P0.coop == 2) cg::this_grid().sync(); }
    }
}

extern "C" void kernel_launch(void* const* d_in, const int* in_sizes, int n_in, void* d_out, int out_size, void* d_ws, size_t ws_size, hipStream_t stream) {
    static int grid = 0;
    if (grid == 0) {
        if (n_in != 21 || out_size != ML * D || ws_size < WS_END) { fprintf(stderr, "kernel_launch: unexpected shapes/workspace (n_in %d out %d ws %zu need %zu)\n", n_in, out_size, ws_size, (size_t)WS_END); grid = -1; return; }
        int dev = 0, cus = 0, per_cu = 0;
        hipGetDevice(&dev);
        hipDeviceGetAttribute(&cus, hipDeviceAttributeMultiprocessorCount, dev);
        hipFuncSetAttribute((const void*)mega, hipFuncAttributeMaxDynamicSharedMemorySize, LDS_BYTES);
        hipOccupancyMaxActiveBlocksPerMultiprocessor(&per_cu, (const void*)mega, NTHREADS, LDS_BYTES);
        if (per_cu < 1) per_cu = 1;
        if (per_cu > 2) per_cu = 2;
        grid = cus * per_cu;
        (void)hipGetLastError();
    }
    if (grid < 0) return;
    Params p{};
    const float** pp = (const float**)&p;
    for (int i = 0; i < 21; ++i) pp[i] = (const float*)d_in[i];
    p.out = (float*)d_out; p.ws = (unsigned char*)d_ws;
#if MK_PER_PHASE
    for (int ph = 0; ph < NPHASES; ++ph) {
        p.ph_lo = ph; p.ph_hi = ph + 1; p.coop = 0;
        hipLaunchKernelGGL(mega, dim3(grid), dim3(NTHREADS), LDS_BYTES, stream, p);
    }
#else
    p.ph_lo = 0; p.ph_hi = NPHASES; p.coop = 1;
    (void)hipMemsetAsync(d_ws, 0, BAR_BYTES, stream);
    void* args[] = {&p};
    hipError_t e = hipLaunchCooperativeKernel((const void*)mega, dim3(grid), dim3(NTHREADS), args, LDS_BYTES, stream);
    if (e != hipSuccess) fprintf(stderr, "cooperative launch failed: %s (grid %d)\n", hipGetErrorString(e), grid);
#endif
}
```
